# Optimizing an MI355X kernel written in HIP

```python
import jax, jax.numpy as jnp
from jax import lax
import numpy as np

D_MODEL = 1024
BATCH = 4
SEQ = 4096
DEPTH = 2

GRID_W = 64
CTX_LEN = 256
CONV_CH = 256
CONV_WIDTH = 31
NAT_HEADS = 4
NAT_HEAD_DIM = 64
NAT_W = NAT_HEADS * NAT_HEAD_DIM
NAT_KH = 8
NAT_KW = 16
FNET_GROUPS = 4
FNET_GROUP_DIM = 64
FNET_W = FNET_GROUPS * FNET_GROUP_DIM
GQA_Q_HEADS = 8
GQA_KV_HEADS = 2
GQA_HEAD_DIM = 64
GQA_Q_W = GQA_Q_HEADS * GQA_HEAD_DIM
GQA_KV_W = GQA_KV_HEADS * GQA_HEAD_DIM
GQA_WINDOW = 128
GQA_BLOCK = 128
ROPE_BASE = 10000.0
PEER_HEADS = 8
PEER_N_KEYS = 128
PEER_N_EXPERTS = PEER_N_KEYS * PEER_N_KEYS
PEER_TOPK = 16
PEER_D_KEY = 256
PEER_CHUNK = 128
N_BRANCH = 4
LN_EPS = 1e-5
NEG_INF = -1e30
DEEPNORM_ALPHA = (2 * DEPTH) ** 0.25
DEEPNORM_BETA = (8 * DEPTH) ** -0.25
IN_SIZES = (2 * CONV_CH, NAT_W, NAT_W, NAT_W, FNET_W, GQA_Q_W, GQA_KV_W, GQA_KV_W, N_BRANCH * D_MODEL)
IN_TOTAL = sum(IN_SIZES)

kernel_name = "hybrid_parallel_branch_peer_diffusion_block"


def layer_norm(x, g=None, b=None):
    xf = x.astype(jnp.float32)
    mu = jnp.mean(xf, -1, keepdims=True)
    var = jnp.mean(jnp.square(xf - mu), -1, keepdims=True)
    y = (xf - mu) * lax.rsqrt(var + LN_EPS)
    if g is not None:
        y = y * g.astype(jnp.float32) + b.astype(jnp.float32)
    return y.astype(x.dtype)


def modulate(x, shift, scale):
    return layer_norm(x) * (1.0 + scale) + shift


def split_in(p):
    offs = np.cumsum(IN_SIZES)[:-1].tolist()
    return jnp.split(p, offs, axis=-1)


def to_heads(t, h):
    return t.reshape(*t.shape[:-1], h, t.shape[-1] // h)


def conformer_conv(p_conv, conv_w, conv_b, ln_g, ln_b):
    a, g = jnp.split(p_conv, 2, axis=-1)
    h = a * jax.nn.sigmoid(g)
    h = lax.conv_general_dilated(h, conv_w[:, None, :], window_strides=(1,),
                                 padding=[(CONV_WIDTH // 2, CONV_WIDTH // 2)],
                                 dimension_numbers=('NWC', 'WIO', 'NWC'),
                                 feature_group_count=CONV_CH) + conv_b
    return jax.nn.silu(layer_norm(h, ln_g, ln_b))


def fourier_mix(p_f):
    B, T, _ = p_f.shape
    h = p_f.astype(jnp.float32).reshape(B, T, FNET_GROUPS, FNET_GROUP_DIM)
    h = jnp.fft.fftn(h, axes=(1, 3), norm='ortho').real
    return h.reshape(B, T, FNET_W).astype(p_f.dtype)


def axial_rope(x, rows, cols):
    half = x.shape[-1] // 2
    quarter = half // 2
    freqs = ROPE_BASE ** (-jnp.arange(quarter, dtype=jnp.float32) / quarter)

    def rot(xa, pos):
        ang = pos.astype(jnp.float32)[:, None] * freqs
        cos = jnp.cos(ang)[None, :, None, :]
        sin = jnp.sin(ang)[None, :, None, :]
        x1, x2 = xa[..., :quarter], xa[..., quarter:]
        return jnp.concatenate([x1 * cos - x2 * sin, x1 * sin + x2 * cos], -1)

    xf = x.astype(jnp.float32)
    out = jnp.concatenate([rot(xf[..., :half], rows), rot(xf[..., half:], cols)], -1)
    return out.astype(x.dtype)


def context_attention(q, k, v):
    B, L, H, dh = q.shape
    s = jnp.einsum('blhd,bmhd->bhlm', q, k).astype(jnp.float32) * dh ** -0.5
    p = jax.nn.softmax(s, -1).astype(q.dtype)
    return jnp.einsum('bhlm,bmhd->blhd', p, v).reshape(B, L, H * dh)


def neighbourhood_attention(q, k, v, kc, vc, rpb):
    B, S, H, dh = q.shape
    rows = S // GRID_W
    kh = min(NAT_KH, rows)
    scale = dh ** -0.5
    qg = q.reshape(B, rows, GRID_W, H, dh)
    kg = k.reshape(B, rows, GRID_W, H, dh)
    vg = v.reshape(B, rows, GRID_W, H, dh)
    col = jnp.arange(GRID_W)
    cstart = jnp.clip(col - NAT_KW // 2, 0, GRID_W - NAT_KW)
    cidx = cstart[:, None] + jnp.arange(NAT_KW)[None, :]
    dc = cidx - col[:, None] + (NAT_KW - 1)

    def one_row(r):
        rstart = jnp.clip(r - kh // 2, 0, rows - kh)
        q_r = lax.dynamic_index_in_dim(qg, r, axis=1, keepdims=False)
        k_band = lax.dynamic_slice_in_dim(kg, rstart, kh, axis=1)
        v_band = lax.dynamic_slice_in_dim(vg, rstart, kh, axis=1)
        k_nb = k_band[:, :, cidx]
        v_nb = v_band[:, :, cidx]
        dr = rstart + jnp.arange(kh) - r + (NAT_KH - 1)
        bias = rpb[:, dr][:, :, dc].transpose(0, 2, 1, 3)
        s_nb = jnp.einsum('bchd,bwckhd->bhcwk', q_r, k_nb).astype(jnp.float32) * scale
        s_nb = (s_nb + bias[None].astype(jnp.float32)).reshape(B, H, GRID_W, kh * NAT_KW)
        s_ctx = jnp.einsum('bchd,blhd->bhcl', q_r, kc).astype(jnp.float32) * scale
        probs = jax.nn.softmax(jnp.concatenate([s_nb, s_ctx], -1), -1).astype(q.dtype)
        p_nb = probs[..., :kh * NAT_KW].reshape(B, H, GRID_W, kh, NAT_KW)
        p_ctx = probs[..., kh * NAT_KW:]
        return (jnp.einsum('bhcwk,bwckhd->bchd', p_nb, v_nb)
                + jnp.einsum('bhcl,blhd->bchd', p_ctx, vc))

    out = lax.map(one_row, jnp.arange(rows))
    return out.transpose(1, 0, 2, 3, 4).reshape(B, S, H * dh)


def window_gqa_latent(q, k, v, kc, vc, sink):
    B, S, _, dh = q.shape
    G = GQA_KV_HEADS
    R = GQA_Q_HEADS // G
    L = kc.shape[1]
    nb = S // GQA_BLOCK
    scale = dh ** -0.5
    qb = q.reshape(B, nb, GQA_BLOCK, G, R, dh)
    pad = ((0, 0), (GQA_BLOCK, GQA_BLOCK), (0, 0), (0, 0))
    kp = jnp.pad(k, pad).reshape(B, nb + 2, GQA_BLOCK, G, dh)
    vp = jnp.pad(v, pad).reshape(B, nb + 2, GQA_BLOCK, G, dh)
    kband = jnp.concatenate([kp[:, :-2], kp[:, 1:-1], kp[:, 2:]], axis=2)
    vband = jnp.concatenate([vp[:, :-2], vp[:, 1:-1], vp[:, 2:]], axis=2)
    qpos = jnp.arange(S).reshape(nb, GQA_BLOCK)
    kpos = jnp.arange(nb)[:, None] * GQA_BLOCK - GQA_BLOCK + jnp.arange(3 * GQA_BLOCK)[None, :]
    kp3 = kpos[:, None, :]
    valid = (jnp.abs(kp3 - qpos[:, :, None]) <= GQA_WINDOW) & (kp3 >= 0) & (kp3 < S)
    s_band = jnp.einsum('bnqgrd,bnkgd->bgrnqk', qb, kband).astype(jnp.float32) * scale
    s_band = jnp.where(valid, s_band, NEG_INF)
    s_ctx = jnp.einsum('bnqgrd,blgd->bgrnql', qb, kc).astype(jnp.float32) * scale
    s_sink = jnp.broadcast_to(sink.astype(jnp.float32).reshape(1, G, R, 1, 1, 1),
                              (B, G, R, nb, GQA_BLOCK, 1))
    probs = jax.nn.softmax(jnp.concatenate([s_band, s_ctx, s_sink], -1), -1).astype(q.dtype)
    nk = 3 * GQA_BLOCK
    out = (jnp.einsum('bgrnqk,bnkgd->bnqgrd', probs[..., :nk], vband)
           + jnp.einsum('bgrnql,blgd->bnqgrd', probs[..., nk:nk + L], vc))
    return out.reshape(B, S, GQA_Q_HEADS * dh)


def gqa_context(q, k, v, sink):
    B, L, _, dh = q.shape
    G = GQA_KV_HEADS
    R = GQA_Q_HEADS // G
    qg = q.reshape(B, L, G, R, dh)
    s = jnp.einsum('blgrd,bmgd->bgrlm', qg, k).astype(jnp.float32) * dh ** -0.5
    s_sink = jnp.broadcast_to(sink.astype(jnp.float32).reshape(1, G, R, 1, 1), (B, G, R, L, 1))
    probs = jax.nn.softmax(jnp.concatenate([s, s_sink], -1), -1)[..., :L].astype(q.dtype)
    return jnp.einsum('bgrlm,bmgd->blgrd', probs, v).reshape(B, L, GQA_Q_HEADS * dh)


def merge_branches(y_a, y_b, y_c, y_d, gate_logits, w_a, w_b, w_c, w_d, w_o):
    g = jax.nn.sigmoid(gate_logits).reshape(*gate_logits.shape[:-1], N_BRANCH, D_MODEL)
    m = (g[..., 0, :] * (y_a @ w_a) + g[..., 1, :] * (y_b @ w_b)
         + g[..., 2, :] * (y_c @ w_c) + g[..., 3, :] * (y_d @ w_d))
    return m @ w_o


def peer_ffn(u, wq, k1, k2, eu, ev):
    B, T, D = u.shape
    xs = u.reshape(-1, PEER_CHUNK, D)
    half = PEER_D_KEY // 2

    def chunk(xc):
        q = (xc @ wq).reshape(PEER_CHUNK, PEER_HEADS, 2, half)
        s1 = jnp.einsum('thd,hnd->thn', q[:, :, 0], k1).astype(jnp.float32)
        s2 = jnp.einsum('thd,hnd->thn', q[:, :, 1], k2).astype(jnp.float32)
        v1, i1 = lax.top_k(s1, PEER_TOPK)
        v2, i2 = lax.top_k(s2, PEER_TOPK)
        cand = (v1[..., :, None] + v2[..., None, :]).reshape(PEER_CHUNK, PEER_HEADS, -1)
        cidx = (i1[..., :, None] * PEER_N_KEYS + i2[..., None, :]).reshape(PEER_CHUNK, PEER_HEADS, -1)
        top_s, pos = lax.top_k(cand, PEER_TOPK)
        eidx = jnp.take_along_axis(cidx, pos, -1)
        g = jax.nn.softmax(top_s, -1).astype(xc.dtype)
        h = jax.nn.gelu(jnp.einsum('thkd,td->thk', eu[eidx], xc), approximate=False)
        return jnp.einsum('thk,thkd->td', g * h, ev[eidx])

    return lax.map(chunk, xs).reshape(B, T, D)


def setup_inputs(seed: int = 0) -> dict:
    key = jax.random.key(seed)
    ks = jax.random.split(key, 28)
    f32 = jnp.float32
    D = D_MODEL
    L = DEPTH

    def nrm(k, shape, s):
        return jax.random.normal(k, shape, f32) * s

    return {
        "x": nrm(ks[0], (BATCH, SEQ, D), 1.0),
        "c": nrm(ks[1], (BATCH, D), 1.0),
        "ctx": nrm(ks[2], (BATCH, CTX_LEN, D), 1.0),
        "c_ctx": nrm(ks[3], (D,), 1.0),
        "w_ada": nrm(ks[4], (L, D, 6 * D), D ** -0.5),
        "b_ada": nrm(ks[5], (L, 6 * D), 0.01),
        "w_in": nrm(ks[6], (L, D, IN_TOTAL), D ** -0.5),
        "b_in": nrm(ks[7], (L, IN_TOTAL), 0.01),
        "conv_w": nrm(ks[8], (L, CONV_WIDTH, CONV_CH), CONV_WIDTH ** -0.5),
        "conv_b": nrm(ks[9], (L, CONV_CH), 0.01),
        "conv_ln_g": 1.0 + nrm(ks[10], (L, CONV_CH), 0.1),
        "conv_ln_b": nrm(ks[11], (L, CONV_CH), 0.01),
        "nat_rpb": nrm(ks[12], (L, NAT_HEADS, 2 * NAT_KH - 1, 2 * NAT_KW - 1), 0.1),
        "gqa_sink": nrm(ks[13], (L, GQA_Q_HEADS), 1.0),
        "w_branch_a": nrm(ks[14], (L, CONV_CH, D), CONV_CH ** -0.5),
        "w_branch_b": nrm(ks[15], (L, NAT_W, D), NAT_W ** -0.5),
        "w_branch_c": nrm(ks[16], (L, FNET_W, D), FNET_W ** -0.5),
        "w_branch_d": nrm(ks[17], (L, GQA_Q_W, D), GQA_Q_W ** -0.5),
        "w_out": nrm(ks[18], (L, D, D), D ** -0.5 * DEEPNORM_BETA),
        "ln1_g": 1.0 + nrm(ks[19], (L, D), 0.1),
        "ln1_b": nrm(ks[20], (L, D), 0.01),
        "peer_wq": nrm(ks[21], (L, D, PEER_HEADS * PEER_D_KEY), D ** -0.5),
        "peer_k1": nrm(ks[22], (L, PEER_HEADS, PEER_N_KEYS, PEER_D_KEY // 2), (PEER_D_KEY // 2) ** -0.5),
        "peer_k2": nrm(ks[23], (L, PEER_HEADS, PEER_N_KEYS, PEER_D_KEY // 2), (PEER_D_KEY // 2) ** -0.5),
        "peer_u": nrm(ks[24], (L, PEER_N_EXPERTS, D), D ** -0.5),
        "peer_v": nrm(ks[25], (L, PEER_N_EXPERTS, D), DEEPNORM_BETA),
        "ln2_g": 1.0 + nrm(ks[26], (L, D), 0.1),
        "ln2_b": nrm(ks[27], (L, D), 0.01),
    }


def reference(x, c, ctx, c_ctx, w_ada, b_ada, w_in, b_in, conv_w, conv_b, conv_ln_g, conv_ln_b,
              nat_rpb, gqa_sink, w_branch_a, w_branch_b, w_branch_c, w_branch_d, w_out,
              ln1_g, ln1_b, peer_wq, peer_k1, peer_k2, peer_u, peer_v, ln2_g, ln2_b):
    S = x.shape[1]
    t = jnp.arange(S)
    pos_row = t // GRID_W
    pos_col = t % GRID_W
    xc = ctx
    for i in range(DEPTH):
        mod_l = (jax.nn.silu(c) @ w_ada[i] + b_ada[i])[:, None, :]
        mod_c = jax.nn.silu(c_ctx) @ w_ada[i] + b_ada[i]
        sh1_l, sc1_l, g1_l, sh2_l, sc2_l, g2_l = jnp.split(mod_l, 6, axis=-1)
        sh1_c, sc1_c, g1_c, sh2_c, sc2_c, g2_c = jnp.split(mod_c, 6, axis=-1)

        pc = modulate(xc, sh1_c, sc1_c) @ w_in[i] + b_in[i]
        c_conv, c_nq, c_nk, c_nv, c_f, c_gq, c_gk, c_gv, c_gate = split_in(pc)
        nk_c = to_heads(c_nk, NAT_HEADS)
        nv_c = to_heads(c_nv, NAT_HEADS)
        gk_c = to_heads(c_gk, GQA_KV_HEADS)
        gv_c = to_heads(c_gv, GQA_KV_HEADS)

        pl = modulate(x, sh1_l, sc1_l) @ w_in[i] + b_in[i]
        l_conv, l_nq, l_nk, l_nv, l_f, l_gq, l_gk, l_gv, l_gate = split_in(pl)
        y_a = conformer_conv(l_conv, conv_w[i], conv_b[i], conv_ln_g[i], conv_ln_b[i])
        y_b = neighbourhood_attention(to_heads(l_nq, NAT_HEADS), to_heads(l_nk, NAT_HEADS),
                                      to_heads(l_nv, NAT_HEADS), nk_c, nv_c, nat_rpb[i])
        y_c = fourier_mix(l_f)
        y_d = window_gqa_latent(axial_rope(to_heads(l_gq, GQA_Q_HEADS), pos_row, pos_col),
                                axial_rope(to_heads(l_gk, GQA_KV_HEADS), pos_row, pos_col),
                                to_heads(l_gv, GQA_KV_HEADS), gk_c, gv_c, gqa_sink[i])
        mix = merge_branches(y_a, y_b, y_c, y_d, l_gate, w_branch_a[i], w_branch_b[i],
                             w_branch_c[i], w_branch_d[i], w_out[i])
        x = layer_norm(DEEPNORM_ALPHA * x + g1_l * mix, ln1_g[i], ln1_b[i])
        ffn = peer_ffn(modulate(x, sh2_l, sc2_l), peer_wq[i], peer_k1[i], peer_k2[i], peer_u[i], peer_v[i])
        x = layer_norm(DEEPNORM_ALPHA * x + g2_l * ffn, ln2_g[i], ln2_b[i])

        if i < DEPTH - 1:
            yc_a = conformer_conv(c_conv, conv_w[i], conv_b[i], conv_ln_g[i], conv_ln_b[i])
            yc_b = context_attention(to_heads(c_nq, NAT_HEADS), nk_c, nv_c)
            yc_c = fourier_mix(c_f)
            yc_d = gqa_context(to_heads(c_gq, GQA_Q_HEADS), gk_c, gv_c, gqa_sink[i])
            mix_c = merge_branches(yc_a, yc_b, yc_c, yc_d, c_gate, w_branch_a[i], w_branch_b[i],
                                   w_branch_c[i], w_branch_d[i], w_out[i])
            xc = layer_norm(DEEPNORM_ALPHA * xc + g1_c * mix_c, ln1_g[i], ln1_b[i])
            ffn_c = peer_ffn(modulate(xc, sh2_c, sc2_c), peer_wq[i], peer_k1[i], peer_k2[i],
                             peer_u[i], peer_v[i])
            xc = layer_norm(DEEPNORM_ALPHA * xc + g2_c * ffn_c, ln2_g[i], ln2_b[i])
    return x
```

```cpp
#include <hip/hip_runtime.h>
#include <cstdio>
#include <cstdint>

typedef unsigned short bf16_t;
typedef unsigned int u32;

#define NBATCH 4
#define SEQ 4096
#define CTXL 256
#define NLAT (NBATCH * SEQ)
#define NCTX (NBATCH * CTXL)
#define NROWS (NLAT + NCTX)
#define INTOT 6400
#define PLW 1664
#define PL_CONV 0
#define PL_NQ 512
#define PL_NK 768
#define PL_GQ 1024
#define PL_GK 1536
#define YW 1280
#define LN_EPS 1e-5f
#define ALPHA 1.41421356237f
#define NTHREADS 256

constexpr size_t al256(size_t x) { return (x + 255) & ~(size_t)255; }
constexpr size_t OFF_CTL  = 0;
constexpr size_t OFF_MODS = 65536;
constexpr size_t OFF_XLN  = al256(OFF_MODS + 2 * 5 * 6144 * 4);
constexpr size_t OFF_M    = OFF_XLN;
constexpr size_t OFF_Y    = al256(OFF_XLN + (size_t)NROWS * 1024 * 2);
constexpr size_t OFF_XC2  = al256(OFF_Y + (size_t)NROWS * YW * 2);
constexpr size_t OFF_PL   = al256(OFF_XC2 + (size_t)NCTX * 1024 * 4);
constexpr size_t OFF_G8   = al256(OFF_PL + (size_t)NROWS * PLW * 2);
constexpr size_t OFF_NVT  = al256(OFF_G8 + (size_t)NROWS * 4096);
constexpr size_t OFF_NVTC = al256(OFF_NVT + (size_t)4 * 256 * 4096 * 2);
constexpr size_t OFF_GVT  = al256(OFF_NVTC + (size_t)4 * 256 * 256 * 2);
constexpr size_t OFF_GVTC = al256(OFF_GVT + (size_t)4 * 128 * 4096 * 2);
constexpr size_t OFF_HT   = al256(OFF_GVTC + (size_t)4 * 128 * 256 * 2);
constexpr size_t OFF_HTC  = al256(OFF_HT + (size_t)4 * 256 * 8192 * 2);
constexpr size_t OFF_PLEND0 = al256(OFF_HTC + (size_t)4 * 256 * 512 * 2);
constexpr size_t OFF_Z    = OFF_PL;
constexpr size_t OFF_U    = al256(OFF_Z + (size_t)NROWS * 1024 * 4);
constexpr size_t OFF_EIDX = al256(OFF_U + (size_t)NROWS * 1024 * 2);
constexpr size_t OFF_GATE = al256(OFF_EIDX + (size_t)NROWS * 128 * 4);
constexpr size_t OFF_PEND2 = al256(OFF_GATE + (size_t)NROWS * 128 * 4);
constexpr size_t OFF_PLEND = OFF_PLEND0 > OFF_PEND2 ? OFF_PLEND0 : OFF_PEND2;
constexpr size_t OFF_WINT = al256(OFF_PLEND);
constexpr size_t OFF_BINP = al256(OFF_WINT + (size_t)2 * 6656 * 1024 * 2);
constexpr size_t OFF_WBRT = al256(OFF_BINP + (size_t)2 * 6656 * 4);
constexpr size_t WBRT_L   = (size_t)1024 * 1280;
constexpr size_t OFF_WOT  = al256(OFF_WBRT + 2 * WBRT_L * 2);
constexpr size_t OFF_WQT  = al256(OFF_WOT + (size_t)2 * 1024 * 1024 * 2);
constexpr size_t OFF_K12  = al256(OFF_WQT + (size_t)2 * 2048 * 1024 * 2);
constexpr size_t OFF_EUV  = al256(OFF_K12 + (size_t)2 * 2 * 8 * 128 * 128 * 2);
constexpr size_t OFF_TWC  = al256(OFF_EUV + (size_t)2 * 2 * 16384 * 768);
constexpr size_t OFF_FB1  = al256(OFF_TWC + (size_t)256 * 512 * 2);
constexpr size_t OFF_FB3  = al256(OFF_FB1 + (size_t)128 * 128 * 2);
constexpr size_t OFF_HT2  = OFF_HT;
constexpr size_t WS_END   = al256(OFF_FB3 + (size_t)64 * 128 * 2);

struct Params {
    const float* in[28];
    float* out;
    unsigned char* ws;
    int ph_lo, ph_hi;
};

__device__ __forceinline__ float bf2f(bf16_t v) { return __uint_as_float(((u32)v) << 16); }
__device__ __forceinline__ bf16_t f2bf(float f) { return __builtin_bit_cast(bf16_t, (__bf16)f); }
__device__ __forceinline__ float sigmoid_f(float x) { return __builtin_amdgcn_rcpf(1.f + __builtin_amdgcn_exp2f(x * -1.4426950409f)); }
__device__ __forceinline__ float silu_f(float x) { return x / (1.f + __expf(-x)); }
template <int CTRL> __device__ __forceinline__ float dpp_f(float v) { return __builtin_bit_cast(float, __builtin_amdgcn_update_dpp(0, __builtin_bit_cast(int, v), CTRL, 0xf, 0xf, true)); }
__device__ __forceinline__ void swap16(float& a, float& b) { asm volatile("s_nop 1\n\tv_permlane16_swap_b32 %0, %1" : "+v"(a), "+v"(b)); }
__device__ __forceinline__ void swap32(float& a, float& b) { asm volatile("s_nop 1\n\tv_permlane32_swap_b32 %0, %1" : "+v"(a), "+v"(b)); }
#define DPP_XOR1 0xB1
#define DPP_XOR2 0x4E
#define DPP_HALF_MIRROR 0x141
#define DPP_MIRROR 0x140
#define DPP_ROR8 0x128
__device__ __forceinline__ float sum8(float v) { v += dpp_f<DPP_XOR1>(v); v += dpp_f<DPP_XOR2>(v); v += dpp_f<DPP_HALF_MIRROR>(v); return v; }
__device__ __forceinline__ float xsum16(float v) { float a = v, b = v; swap16(a, b); return a + b; }
__device__ __forceinline__ float xsum32(float v) { float a = v, b = v; swap32(a, b); return a + b; }
__device__ __forceinline__ float xmax16(float v) { float a = v, b = v; swap16(a, b); return fmaxf(a, b); }
__device__ __forceinline__ float xmax32(float v) { float a = v, b = v; swap32(a, b); return fmaxf(a, b); }
__device__ __forceinline__ float wave_sum(float v) { v = sum8(v); v += dpp_f<DPP_MIRROR>(v); return xsum32(xsum16(v)); }
__device__ __forceinline__ void sincos_red(float a, float& s, float& c) {
    const float k = rintf(a * 0.15915494309189535f);
    float x = fmaf(-k, 6.2831854820251465f, a);
    x = fmaf(-k, -1.7484555e-7f, x);
    s = __sinf(x); c = __cosf(x);
}
__device__ __forceinline__ float gelu_erf(float x) { return 0.5f * x * (1.f + erff(x * 0.70710678118f)); }

#define XB_TMO      128
#define XB_XCNT(j)  (256  + 64 * (j))
#define XB_XSUB(j)  (1280 + 64 * (j))
#define XB_XGEN(j)  (2304 + 64 * (j))
#define XB_TOP      3328
#define XB_TOPGEN   3392
#define XCD_BAR_WORDS 3456
#define XB_SPIN_CAP (1u << 22)
#define LAS __attribute__((address_space(3)))
__device__ __forceinline__ unsigned xb_ld(unsigned* p)              { return __hip_atomic_load(p, __ATOMIC_RELAXED, __HIP_MEMORY_SCOPE_AGENT); }
__device__ __forceinline__ unsigned xb_add(unsigned* p, unsigned v) { return __hip_atomic_fetch_add(p, v, __ATOMIC_RELAXED, __HIP_MEMORY_SCOPE_AGENT); }
__device__ __forceinline__ unsigned xb_xcc_id() { return (unsigned)__builtin_amdgcn_s_getreg((3 << 11) | 20) & 0xFu; }
#define XB_SPIN(cond, bar) do { unsigned _sp = 0; while (cond) { __builtin_amdgcn_s_sleep(1); \
    if ((++_sp & 255u) == 0u) { if (xb_ld(&(bar)[XB_TMO])) break; if (_sp > XB_SPIN_CAP) { atomicAdd(&(bar)[XB_TMO], 1u); break; } } } } while (0)
struct XcdBarrier { unsigned* bar; unsigned x; volatile LAS unsigned* st; };
__device__ __forceinline__ XcdBarrier xcd_barrier_post(unsigned* bar, volatile LAS unsigned* st) {
    XcdBarrier b; b.bar = bar; b.x = xb_xcc_id(); b.st = st;
    if (threadIdx.x == 0) (void)xb_add(&bar[XB_XCNT(b.x)], 1u);
    return b;
}
__device__ __forceinline__ void xcd_barrier_complete(unsigned* bar, unsigned x, unsigned& nloc, unsigned& nx) {
    const unsigned G = gridDim.x * gridDim.y * gridDim.z;
    unsigned sum, cnt, mine, sp = 0u;
    for (;;) {
        sum = 0u; cnt = 0u; mine = 0u;
#pragma unroll
        for (unsigned j = 0; j < 16; ++j) { const unsigned c = xb_ld(&bar[XB_XCNT(j)]); sum += c; cnt += (c > 0u) ? 1u : 0u; mine = (j == x) ? c : mine; }
        if (sum == G) break;
        __builtin_amdgcn_s_sleep(1);
        if ((++sp & 255u) == 0u) { if (xb_ld(&bar[XB_TMO])) break; if (sp > XB_SPIN_CAP) { atomicAdd(&bar[XB_TMO], 1u); break; } }
    }
    nloc = mine > 0u ? mine : 1u; nx = cnt > 0u ? cnt : 1u;
}
__device__ __forceinline__ void xcd_barrier(const XcdBarrier& b) {
    asm volatile("s_waitcnt vmcnt(0)" ::: "memory");
    __syncthreads();
    if (threadIdx.x == 0) {
        unsigned* bar = b.bar;
        __builtin_amdgcn_s_waitcnt(0);
        unsigned nloc = b.st[0], nx = b.st[1];
        if (nloc == 0u) { xcd_barrier_complete(bar, b.x, nloc, nx); b.st[0] = nloc; b.st[1] = nx; }
        const unsigned old = xb_add(&bar[XB_XSUB(b.x)], 1u);
        const unsigned gen = old / nloc;
        if (old + 1u == (gen + 1u) * nloc) {
            __builtin_amdgcn_fence(__ATOMIC_RELEASE, "agent");
            asm volatile("s_waitcnt vmcnt(0)" ::: "memory");
            const unsigned og = xb_add(&bar[XB_TOP], 1u);
            const unsigned tg = og / nx;
            if (og + 1u == (tg + 1u) * nx) xb_add(&bar[XB_TOPGEN], 1u);
            else XB_SPIN(xb_ld(&bar[XB_TOPGEN]) == tg, bar);
            __builtin_amdgcn_fence(__ATOMIC_ACQUIRE, "agent");
            xb_add(&bar[XB_XGEN(b.x)], 1u);
            asm volatile("s_waitcnt vmcnt(0)" ::: "memory");
        } else {
            XB_SPIN(xb_ld(&bar[XB_XGEN(b.x)]) == gen, bar);
            __builtin_amdgcn_fence(__ATOMIC_ACQUIRE, "agent");
            asm volatile("s_waitcnt vmcnt(0)" ::: "memory");
        }
    }
    __syncthreads();
}

__device__ __forceinline__ int opq_tid() { int t = threadIdx.x; asm volatile("" : "+v"(t)); return t; }
typedef short bf16x8 __attribute__((ext_vector_type(8)));
typedef float f32x4 __attribute__((ext_vector_type(4)));
typedef unsigned u32x2 __attribute__((ext_vector_type(2)));
typedef unsigned u32x4 __attribute__((ext_vector_type(4)));
typedef __bf16 bf16x2v __attribute__((ext_vector_type(2)));
__device__ __forceinline__ u32 pk2(float lo, float hi) { const bf16x2v t = {(__bf16)lo, (__bf16)hi}; return __builtin_bit_cast(u32, t); }
__device__ __forceinline__ uint2 pk4(f32x4 v) { uint2 r; r.x = pk2(v[0], v[1]); r.y = pk2(v[2], v[3]); return r; }
__device__ __forceinline__ int row_mod(int r) { return r < NLAT ? (r >> 12) : 4; }

__device__ __forceinline__ void ph_lnmod(const Params& p, int l, const float* xlat, const float* xctx, int vb, int nblk) {
    const int tidx = opq_tid();
    const int wave = tidx >> 6, lane = tidx & 63;
    const float* mods = (const float*)(p.ws + OFF_MODS) + (size_t)l * 5 * 6144;
    bf16_t* XLN = (bf16_t*)(p.ws + OFF_XLN);
    for (int r = vb * 4 + wave; r < NROWS; r += nblk * 4) {
        const float* src = r < NLAT ? xlat + (size_t)r * 1024 : xctx + (size_t)(r - NLAT) * 1024;
        const float* sh = mods + (size_t)row_mod(r) * 6144; const float* sc = sh + 1024;
        float4 v[4]; float s = 0.f;
#pragma unroll
        for (int j = 0; j < 4; ++j) { v[j] = ((const float4*)src)[lane + 64 * j]; s += (v[j].x + v[j].y) + (v[j].z + v[j].w); }
        const float mean = wave_sum(s) * (1.f / 1024.f); float q = 0.f;
#pragma unroll
        for (int j = 0; j < 4; ++j) { v[j].x -= mean; v[j].y -= mean; v[j].z -= mean; v[j].w -= mean; q += (v[j].x * v[j].x + v[j].y * v[j].y) + (v[j].z * v[j].z + v[j].w * v[j].w); }
        const float rstd = rsqrtf(wave_sum(q) * (1.f / 1024.f) + LN_EPS);
#pragma unroll
        for (int j = 0; j < 4; ++j) {
            const int i0 = (lane + 64 * j) * 4;
            const float4 a = *(const float4*)(sc + i0), b = *(const float4*)(sh + i0);
            ushort4 o;
            o.x = f2bf(v[j].x * rstd * (1.f + a.x) + b.x); o.y = f2bf(v[j].y * rstd * (1.f + a.y) + b.y);
            o.z = f2bf(v[j].z * rstd * (1.f + a.z) + b.z); o.w = f2bf(v[j].w * rstd * (1.f + a.w) + b.w);
            *(ushort4*)(XLN + (size_t)r * 1024 + i0) = o;
        }
    }
}

__device__ __forceinline__ void ph_ln1(const Params& p, int l, int nrows, int vb, int nblk) {
    const int tidx = opq_tid();
    const int wave = tidx >> 6, lane = tidx & 63;
    const float* mods = (const float*)(p.ws + OFF_MODS) + (size_t)l * 5 * 6144;
    const bf16_t* Z = (const bf16_t*)(p.ws + OFF_Z); bf16_t* U = (bf16_t*)(p.ws + OFF_U);
    const float* lg = p.in[19] + l * 1024; const float* lb = p.in[20] + l * 1024;
    const int nw = nblk * 4, w = vb * 4 + wave;
    const int r_lo = (int)(((long long)w * nrows) / nw), r_hi = (int)(((long long)(w + 1) * nrows) / nw);
    f32x4 ga[4], be[4], sc[4], sh[4];
#pragma unroll
    for (int k = 0; k < 4; ++k) { const int i0 = lane * 8 + 512 * (k >> 1) + 4 * (k & 1); ga[k] = *(const f32x4*)(lg + i0); be[k] = *(const f32x4*)(lb + i0); sc[k] = sh[k] = (f32x4){0.f, 0.f, 0.f, 0.f}; }
    int cur = -1;
    for (int r = r_lo; r < r_hi; ++r) {
        const int mi = row_mod(r);
        if (mi != cur) {
            cur = mi; const float* shp = mods + (size_t)mi * 6144 + 3072;
#pragma unroll
            for (int k = 0; k < 4; ++k) { const int i0 = lane * 8 + 512 * (k >> 1) + 4 * (k & 1); sh[k] = *(const f32x4*)(shp + i0); sc[k] = *(const f32x4*)(shp + 1024 + i0) + 1.f; }
        }
        const uint4 t0 = *(const uint4*)(Z + (size_t)r * 1024 + lane * 8), t1 = *(const uint4*)(Z + (size_t)r * 1024 + 512 + lane * 8);
        f32x4 v[4];
        v[0] = (f32x4){__uint_as_float(t0.x << 16), __uint_as_float(t0.x & 0xffff0000u), __uint_as_float(t0.y << 16), __uint_as_float(t0.y & 0xffff0000u)};
        v[1] = (f32x4){__uint_as_float(t0.z << 16), __uint_as_float(t0.z & 0xffff0000u), __uint_as_float(t0.w << 16), __uint_as_float(t0.w & 0xffff0000u)};
        v[2] = (f32x4){__uint_as_float(t1.x << 16), __uint_as_float(t1.x & 0xffff0000u), __uint_as_float(t1.y << 16), __uint_as_float(t1.y & 0xffff0000u)};
        v[3] = (f32x4){__uint_as_float(t1.z << 16), __uint_as_float(t1.z & 0xffff0000u), __uint_as_float(t1.w << 16), __uint_as_float(t1.w & 0xffff0000u)};
        float s = 0.f;
#pragma unroll
        for (int k = 0; k < 4; ++k) s += (v[k][0] + v[k][1]) + (v[k][2] + v[k][3]);
        float mean = wave_sum(s) * (1.f / 1024.f); float q = 0.f;
#pragma unroll
        for (int k = 0; k < 4; ++k) { v[k] = v[k] - mean; q += (v[k][0] * v[k][0] + v[k][1] * v[k][1]) + (v[k][2] * v[k][2] + v[k][3] * v[k][3]); }
        float rstd = rsqrtf(wave_sum(q) * (1.f / 1024.f) + LN_EPS);
        s = 0.f;
#pragma unroll
        for (int k = 0; k < 4; ++k) { v[k] = v[k] * rstd * ga[k] + be[k]; s += (v[k][0] + v[k][1]) + (v[k][2] + v[k][3]); }
        mean = wave_sum(s) * (1.f / 1024.f); q = 0.f;
#pragma unroll
        for (int k = 0; k < 4; ++k) { v[k] = v[k] - mean; q += (v[k][0] * v[k][0] + v[k][1] * v[k][1]) + (v[k][2] * v[k][2] + v[k][3] * v[k][3]); }
        rstd = rsqrtf(wave_sum(q) * (1.f / 1024.f) + LN_EPS);
#pragma unroll
        for (int k = 0; k < 4; ++k) v[k] = v[k] * rstd * sc[k] + sh[k];
        const uint2 o0 = pk4(v[0]), o1 = pk4(v[1]), o2 = pk4(v[2]), o3 = pk4(v[3]);
        *(uint4*)(U + (size_t)r * 1024 + lane * 8) = make_uint4(o0.x, o0.y, o1.x, o1.y); *(uint4*)(U + (size_t)r * 1024 + 512 + lane * 8) = make_uint4(o2.x, o2.y, o3.x, o3.y);
    }
}


__device__ __forceinline__ int perm64(int q) { return (q & ~63) | (q & 3) | (((q >> 4) & 3) << 2) | (((q >> 2) & 3) << 4); }
template <bool BATCH>
__device__ __forceinline__ void prep_transpose(const float* W, int ldw, bf16_t* WT, int ldk, int k0, int n0, int nout0, float* scr, bool perm) {
    const int tid = opq_tid();
    __syncthreads();
    if (BATCH) {
        float tv[16];
#pragma unroll
        for (int i = 0; i < 16; ++i) tv[i] = W[(size_t)(k0 + i * 4 + (tid >> 6)) * ldw + n0 + (tid & 63)];
#pragma unroll
        for (int i = 0; i < 16; ++i) scr[(i * 4 + (tid >> 6)) * 65 + (tid & 63)] = tv[i];
    } else {
#pragma unroll 4
        for (int i = 0; i < 16; ++i) { const int kk = i * 4 + (tid >> 6), c = tid & 63; scr[kk * 65 + c] = W[(size_t)(k0 + kk) * ldw + n0 + c]; }
    }
    __syncthreads();
    const int n = tid >> 2, kq = (tid & 3) * 16;
    uint4 o0, o1;
    o0.x = pk2(scr[(kq + 0) * 65 + n], scr[(kq + 1) * 65 + n]); o0.y = pk2(scr[(kq + 2) * 65 + n], scr[(kq + 3) * 65 + n]);
    o0.z = pk2(scr[(kq + 4) * 65 + n], scr[(kq + 5) * 65 + n]); o0.w = pk2(scr[(kq + 6) * 65 + n], scr[(kq + 7) * 65 + n]);
    o1.x = pk2(scr[(kq + 8) * 65 + n], scr[(kq + 9) * 65 + n]); o1.y = pk2(scr[(kq + 10) * 65 + n], scr[(kq + 11) * 65 + n]);
    o1.z = pk2(scr[(kq + 12) * 65 + n], scr[(kq + 13) * 65 + n]); o1.w = pk2(scr[(kq + 14) * 65 + n], scr[(kq + 15) * 65 + n]);
    bf16_t* dst = WT + (size_t)(nout0 + (perm ? perm64(n) : n)) * ldk + k0 + kq;
    *(uint4*)dst = o0; *(uint4*)(dst + 8) = o1;
}
__device__ __forceinline__ void prep_convert8k(const float* src, bf16_t* dst) {
#pragma unroll
    for (int rep = 0; rep < 4; ++rep) {
        const size_t e = ((size_t)rep * 256 + opq_tid()) * 8;
        const float4 a = *(const float4*)(src + e), b = *(const float4*)(src + e + 4);
        uint4 o; o.x = pk2(a.x, a.y); o.y = pk2(a.z, a.w); o.z = pk2(b.x, b.y); o.w = pk2(b.z, b.w);
        *(uint4*)(dst + e) = o;
    }
}
#define PREP_TAB_OFF 65536
__device__ __forceinline__ void prep_tables(unsigned char* ldsg) {
    float* tabh = (float*)(ldsg + PREP_TAB_OFF); float* c64 = tabh + 2048; float* s64 = c64 + 64;
    const int tid = opq_tid();
    __syncthreads();
    for (int m = tid; m < 2048; m += NTHREADS) tabh[m] = __cosf((float)m * 0.0015339807878856412f);
    if (tid < 64) { c64[tid] = __cosf((float)tid * 0.09817477042468103f); s64[tid] = __sinf((float)tid * 0.09817477042468103f); }
    __syncthreads();
}
__device__ __forceinline__ float tab_cos(const float* tabh, int m) { m &= 4095; return m < 2048 ? tabh[m] : -tabh[m - 2048]; }

#define PREPA_N1 3072
#define PREPA_N2 512
#define PREPA_N3 2
#define PREPA_N4 384
#define PREPA_TOTAL (PREPA_N1 + PREPA_N2 + PREPA_N3 + PREPA_N4)
#define PREP_SILU_OFF 20480
__device__ __forceinline__ void prep_item_a(const Params& p, int r, unsigned char* ldsg) {
    float* scr = (float*)ldsg;
    const float* c64 = (const float*)(ldsg + PREP_TAB_OFF) + 2048; const float* s64 = c64 + 64;
    const int tid = opq_tid();
    bf16_t* WINT = (bf16_t*)(p.ws + OFF_WINT); float* BINP = (float*)(p.ws + OFF_BINP);
    if (r < PREPA_N1) {
        const int l = r / 1536; r -= l * 1536; const int kt = r / 96, j = r % 96;
        const int o = j < 20 ? j : j + 4; const int n0 = o * 64; const int nout0 = o < 20 ? n0 : n0 + 256;
        prep_transpose<true>(p.in[6] + (size_t)l * 1024 * INTOT, INTOT, WINT + (size_t)l * 6656 * 1024, 1024, kt * 64, n0, nout0, scr, nout0 < 1024 || nout0 >= 2560);
        return;
    } r -= PREPA_N1;
    if (r < PREPA_N2) {
        const int l = r >> 8; const int kt = (r >> 4) & 15, g = (r >> 2) & 3, jp = r & 3;
        const float* W = p.in[6] + (size_t)l * 1024 * INTOT;
        __syncthreads();
        float tv[16];
#pragma unroll
        for (int i = 0; i < 16; ++i) tv[i] = W[(size_t)(kt * 64 + i * 4 + (tid >> 6)) * INTOT + 1280 + g * 64 + (tid & 63)];
#pragma unroll
        for (int i = 0; i < 16; ++i) scr[(i * 4 + (tid >> 6)) * 65 + (tid & 63)] = tv[i];
        __syncthreads();
        const int kk = tid & 63, jq = tid >> 6;
        bf16_t* wt = WINT + (size_t)l * 6656 * 1024 + kt * 64 + kk;
#pragma unroll
        for (int jj = 0; jj < 4; ++jj) {
            const int j = jp * 16 + jq * 4 + jj; float hc = 0.f, hs = 0.f;
#pragma unroll 8
            for (int c = 0; c < 64; ++c) { const float x = scr[kk * 65 + c]; const int m = (j * c) & 63; hc += x * c64[m]; hs += x * s64[m]; }
            wt[(size_t)(1280 + g * 64 + j) * 1024] = f2bf(hc); wt[(size_t)(1536 + g * 64 + j) * 1024] = f2bf(hs);
        }
        return;
    } r -= PREPA_N2;
    if (r < PREPA_N3) {
        const int l = r; const float* b = p.in[7] + (size_t)l * INTOT;
        for (int n = tid; n < 6656; n += NTHREADS) {
            float v;
            const int nl = (n < 1024 || n >= 2560) ? perm64(n) : n;
            if (n < 1280) v = b[nl];
            else if (n < 1792) { const int sc = n >= 1536; const int q = (n - 1280) & 255; const int g = q >> 6, j = q & 63; float a = 0.f;
                for (int c = 0; c < 64; ++c) a += b[1280 + g * 64 + c] * (sc ? s64[(j * c) & 63] : c64[(j * c) & 63]);
                v = a; }
            else v = b[nl - 256];
            BINP[(size_t)l * 6656 + n] = v;
        }
        return;
    } r -= PREPA_N3;
    {
        const float* sl = (const float*)(ldsg + PREP_SILU_OFF);
        const int cl = tid & 31, ks = tid >> 5;
        const int col = r * 32 + cl; const int l = col / 6144, n = col % 6144;
        const float* W = p.in[4] + (size_t)l * 1024 * 6144 + n;
        float a0 = 0.f, a1 = 0.f, a2 = 0.f, a3 = 0.f, a4 = 0.f;
#pragma unroll 32
        for (int k = ks * 128; k < ks * 128 + 128; ++k) {
            const float w = W[(size_t)k * 6144];
            a0 += sl[k] * w; a1 += sl[1024 + k] * w; a2 += sl[2048 + k] * w; a3 += sl[3072 + k] * w; a4 += sl[4096 + k] * w;
        }
        __syncthreads();
        scr[(ks * 5 + 0) * 32 + cl] = a0; scr[(ks * 5 + 1) * 32 + cl] = a1; scr[(ks * 5 + 2) * 32 + cl] = a2; scr[(ks * 5 + 3) * 32 + cl] = a3; scr[(ks * 5 + 4) * 32 + cl] = a4;
        __syncthreads();
        if (tid < 160) {
            const int q = tid >> 5, c2 = tid & 31; const int col2 = r * 32 + c2; const int l2 = col2 / 6144, n2 = col2 % 6144;
            float v = p.in[5][l2 * 6144 + n2];
#pragma unroll
            for (int k8 = 0; k8 < 8; ++k8) v += scr[(k8 * 5 + q) * 32 + c2];
            ((float*)(p.ws + OFF_MODS))[((size_t)l2 * 5 + q) * 6144 + n2] = v;
        }
    }
}
__device__ __forceinline__ void ph_prep_fast(const Params& p, unsigned char* ldsg, int vb, int nblk) {
    prep_tables(ldsg);
    {
        float* sl = (float*)(ldsg + PREP_SILU_OFF);
        for (int i = opq_tid(); i < 5 * 1024; i += NTHREADS) sl[i] = silu_f(i < 4096 ? p.in[1][i] : p.in[3][i - 4096]);
        __syncthreads();
    }
    for (int item = vb; item < PREPA_TOTAL; item += nblk) prep_item_a(p, item, ldsg);
}

#define PREPB_N1 640
#define PREPB_N2 512
#define PREPB_N3 1024
#define PREPB_N4 64
#define PREPB_N8 2
#define PREPB_N6 16
#define PREPB_N7 4096
#define PREPB_TOTAL (PREPB_N1 + PREPB_N2 + PREPB_N3 + PREPB_N4 + PREPB_N6 + PREPB_N8)
#define EU_SCALE 64.f
#define EV_SCALE 4.f
typedef float f32x2 __attribute__((ext_vector_type(2)));
#define EXPERT_BITS 6
#ifndef EU_BITS
#define EU_BITS 6
#endif
#ifndef EV_BITS
#define EV_BITS 4
#endif
#define EXP_ROWB 768
typedef __bf16 bf16x32v __attribute__((ext_vector_type(32)));
typedef float f32x32v __attribute__((ext_vector_type(32)));
typedef unsigned u32x6v __attribute__((ext_vector_type(6)));
typedef unsigned u32x3v __attribute__((ext_vector_type(3)));
__device__ __forceinline__ void prep_euv_item(const Params& p, int l, int it) {
    unsigned char* EUV = p.ws + OFF_EUV;
    const int tbl = it >> 11; const size_t e0 = (size_t)(it & 2047) * 8192;
    const float* src = (tbl == 0 ? p.in[24] : p.in[25]) + (size_t)l * 16384 * 1024 + e0;
    const float sc = tbl == 0 ? EU_SCALE : EV_SCALE;
    const size_t e = (size_t)opq_tid() * 32;
    const size_t el = e0 + e; const int jl = (int)(el >> 5) & 31;
    const int bits = tbl == 0 ? EU_BITS : EV_BITS;
    unsigned char* dst = EUV + (size_t)(l * 2 + tbl) * 16384 * EXP_ROWB + (el >> 10) * (size_t)(bits * 128);
    float x[32];
#pragma unroll
    for (int q = 0; q < 8; ++q) { const float4 v = *(const float4*)(src + e + 4 * q); x[4 * q] = v.x * sc; x[4 * q + 1] = v.y * sc; x[4 * q + 2] = v.z * sc; x[4 * q + 3] = v.w * sc; }
    if (bits == 6) {
        bf16x32v hb;
#pragma unroll
        for (int q = 0; q < 32; ++q) hb[q] = (__bf16)x[q];
        const u32x6v w = __builtin_amdgcn_cvt_scalef32_pk32_fp6_bf16(hb, 1.0f);
        *(uint4*)(dst + 16 * jl) = make_uint4(w[0], w[1], w[2], w[3]); *(uint2*)(dst + 512 + 8 * jl) = make_uint2(w[4], w[5]);
    } else {
        u32 w[4];
#pragma unroll
        for (int q = 0; q < 4; ++q) {
            u32 t = 0u;
            t = __builtin_amdgcn_cvt_scalef32_pk_fp4_f32(t, x[8 * q + 0], x[8 * q + 1], 1.0f, 0);
            t = __builtin_amdgcn_cvt_scalef32_pk_fp4_f32(t, x[8 * q + 2], x[8 * q + 3], 1.0f, 1);
            t = __builtin_amdgcn_cvt_scalef32_pk_fp4_f32(t, x[8 * q + 4], x[8 * q + 5], 1.0f, 2);
            t = __builtin_amdgcn_cvt_scalef32_pk_fp4_f32(t, x[8 * q + 6], x[8 * q + 7], 1.0f, 3);
            w[q] = t;
        }
        *(uint4*)(dst + 16 * jl) = make_uint4(w[0], w[1], w[2], w[3]);
    }
}
__device__ __forceinline__ void prep_item_b(const Params& p, int r, unsigned char* ldsg, int scr_off) {
    float* scr = (float*)(ldsg + scr_off);
    const float* tabh = (const float*)(ldsg + PREP_TAB_OFF);
    const int tid = opq_tid();
    bf16_t* WBRT = (bf16_t*)(p.ws + OFF_WBRT); bf16_t* WOT = (bf16_t*)(p.ws + OFF_WOT); bf16_t* WQT = (bf16_t*)(p.ws + OFF_WQT);
    bf16_t* K12 = (bf16_t*)(p.ws + OFF_K12); bf16_t* TWC = (bf16_t*)(p.ws + OFF_TWC);
    if (r < PREPB_N1) {
        const int l = r / 320; r -= l * 320;
        int br, kt, nt;
        if (r < 192) { br = r >> 6; kt = (r & 63) >> 4; nt = r & 15; } else { br = 3; r -= 192; kt = r >> 4; nt = r & 15; }
        const int K = br < 3 ? 256 : 512;
        const float* W = (br == 0 ? p.in[14] : (br == 1 ? p.in[15] : (br == 2 ? p.in[16] : p.in[17]))) + (size_t)l * K * 1024;
        prep_transpose<false>(W, 1024, WBRT + (size_t)l * WBRT_L + (size_t)br * 1024 * 256, K, kt * 64, nt * 64, nt * 64, scr, true);
        return;
    } r -= PREPB_N1;
    if (r < PREPB_N2) { const int l = r >> 8; const int kt = (r >> 4) & 15, nt = r & 15;
        prep_transpose<false>(p.in[18] + (size_t)l * 1024 * 1024, 1024, WOT + (size_t)l * 1024 * 1024, 1024, kt * 64, nt * 64, nt * 64, scr, true); return; } r -= PREPB_N2;
    if (r < PREPB_N3) { const int l = r >> 9; const int kt = (r >> 5) & 15, nt = r & 31;
        prep_transpose<false>(p.in[21] + (size_t)l * 1024 * 2048, 2048, WQT + (size_t)l * 2048 * 1024, 1024, kt * 64, nt * 64, nt * 64, scr, false); return; } r -= PREPB_N3;
    if (r < PREPB_N4) { const int tbl = r >> 5; const size_t e0 = (size_t)(r & 31) * 8192;
        prep_convert8k((tbl == 0 ? p.in[22] : p.in[23]) + e0, K12 + (size_t)tbl * 262144 + e0); return; } r -= PREPB_N4;
    if (r < PREPB_N6) {
        const int k = r * 16 + (tid >> 4); const int t0 = (tid & 15) * 16; bf16_t* row = TWC + (size_t)k * 512;
        for (int e = 0; e < 16; ++e) { const int m = k * (t0 + e) * 16; row[t0 + e] = f2bf(tab_cos(tabh, m) * (1.f / 128.f)); row[256 + t0 + e] = f2bf(-tab_cos(tabh, m + 3072) * (1.f / 128.f)); }
        return;
    } r -= PREPB_N6;
    if (r < PREPB_N8) {
        const float* c64 = tabh + 2048; const float* s64 = c64 + 64;
        if (r == 0) {
            bf16_t* B1 = (bf16_t*)(p.ws + OFF_FB1);
            for (int i = tid; i < 128 * 128; i += NTHREADS) {
                const int n = i >> 7, k = i & 127; const int d = n >> 1, part = n & 1; const int m = ((k & 63) * d) & 63;
                float v;
                if (part == 0) v = k < 64 ? c64[m] : -s64[m];
                else v = k < 64 ? -s64[m] : -c64[m];
                B1[i] = f2bf(v);
            }
        } else {
            bf16_t* B3 = (bf16_t*)(p.ws + OFF_FB3);
            for (int i = tid; i < 64 * 128; i += NTHREADS) {
                const int c = i >> 7, k = i & 127; const int m = ((k & 63) * c) & 63;
                B3[i] = f2bf((k < 64 ? c64[m] : s64[m]) * (1.f / 512.f));
            }
        }
        return;
    }
}

__device__ __forceinline__ const char* uniform_ptr(const char* q) {
    const unsigned long long v = (unsigned long long)q;
    const u32 lo = __builtin_amdgcn_readfirstlane((u32)v), hi = __builtin_amdgcn_readfirstlane((u32)(v >> 32));
    return (const char*)(((unsigned long long)hi << 32) | lo);
}
#define GEMM_LDS_BYTES 65536
template <bool TR, int NI = 4, int PERMA = 0>
__device__ __forceinline__ void gemm_tile(f32x4 (&acc)[4][NI], const bf16_t* A, int lda, const bf16_t* Bt, int ldb, int K, LAS unsigned char* lds,
                                          bool pre = false, const bf16_t* nA = nullptr, int nlda = 0, const bf16_t* nBt = nullptr, int nldb = 0, bool nperm = false) {
    const int tid = opq_tid(), lane = tid & 63;
    const int wave = __builtin_amdgcn_readfirstlane(tid >> 6);
    const int wr = wave >> 1, wc = wave & 1, fr = lane & 15, fq = lane >> 4;
    const int srow = lane >> 3, sch = (lane & 7) ^ (lane >> 3);
    unsigned offA[4], offB[4];
#pragma unroll
    for (int i = 0; i < 4; ++i) { const int r0_ = 32 * wave + 8 * i + srow; const int r = PERMA == 1 ? (r0_ >> 6) + 64 * perm64(r0_ & 63) : (PERMA == 2 ? perm64(r0_) : r0_);
        offA[i] = (unsigned)(r * lda + sch * 8) * 2u; const int rb = 8 * NI * wave + 8 * i + srow; offB[i] = (unsigned)(rb * ldb + sch * 8) * 2u; }
    const int nk = K >> 6;
    const int aoff = (wr * 64 + fr) * 128, boff = 16384 + (wc * 16 * NI + fr) * 128;
    const int x0 = ((0 + fq) ^ (fr & 7)) << 4, x1 = ((4 + fq) ^ (fr & 7)) << 4;
#pragma unroll
    for (int mi = 0; mi < 4; ++mi)
#pragma unroll
        for (int ni = 0; ni < NI; ++ni) acc[mi][ni] = (f32x4){0.f, 0.f, 0.f, 0.f};
#define GEMM_STAGE(s, kt) do { \
        const char* ga_ = uniform_ptr((const char*)A + (size_t)(kt) * 128); const char* gb_ = uniform_ptr((const char*)Bt + (size_t)(kt) * 128); \
        LAS unsigned char* la_ = lds + (s) * 32768 + wave * 4096; \
        LAS unsigned char* lb_ = lds + (s) * 32768 + 16384 + wave * (NI * 1024); \
        _Pragma("unroll") for (int i_ = 0; i_ < 4; ++i_) { \
            __builtin_amdgcn_global_load_lds((const unsigned*)(ga_ + offA[i_]), (LAS unsigned*)(la_ + i_ * 1024), 16, 0, 0); \
            if (i_ < NI) __builtin_amdgcn_global_load_lds((const unsigned*)(gb_ + offB[i_]), (LAS unsigned*)(lb_ + i_ * 1024), 16, 0, 0); } } while (0)
    if (!pre) {
        __syncthreads();
        GEMM_STAGE(0, 0);
    }
    bf16x8 a0[4], b0[NI], a1[4], b1[NI];
#define GEMM_RD(av, bv, base_, xo_) do { \
        _Pragma("unroll") for (int mi = 0; mi < 4; ++mi) av[mi] = *(const LAS bf16x8*)((base_) + aoff + mi * 2048 + (xo_)); \
        _Pragma("unroll") for (int ni = 0; ni < NI; ++ni) bv[ni] = *(const LAS bf16x8*)((base_) + boff + ni * 2048 + (xo_)); } while (0)
#define GEMM_MM(av, bv) do { \
        _Pragma("unroll") for (int mi = 0; mi < 4; ++mi) \
        _Pragma("unroll") for (int ni = 0; ni < NI; ++ni) \
            acc[mi][ni] = TR ? __builtin_amdgcn_mfma_f32_16x16x32_bf16(bv[ni], av[mi], acc[mi][ni], 0, 0, 0) \
                             : __builtin_amdgcn_mfma_f32_16x16x32_bf16(av[mi], bv[ni], acc[mi][ni], 0, 0, 0); } while (0)
#define GEMM_SCHED_RD() do { \
        _Pragma("unroll") for (int i_ = 0; i_ < 4 + NI; ++i_) { __builtin_amdgcn_sched_group_barrier(0x008, 2, 0); __builtin_amdgcn_sched_group_barrier(0x100, 1, 0); } \
        __builtin_amdgcn_sched_group_barrier(0x008, 4 * NI - 2 * (4 + NI) > 0 ? 4 * NI - 2 * (4 + NI) : 0, 0); __builtin_amdgcn_sched_barrier(0); } while (0)
#define GEMM_SCHED_VM_RD() do { \
        _Pragma("unroll") for (int i_ = 0; i_ < 4 + NI; ++i_) { __builtin_amdgcn_sched_group_barrier(0x008, 1, 0); __builtin_amdgcn_sched_group_barrier(0x020, 1, 0); \
                                                                 __builtin_amdgcn_sched_group_barrier(0x008, 1, 0); __builtin_amdgcn_sched_group_barrier(0x100, 1, 0); } \
        __builtin_amdgcn_sched_group_barrier(0x008, 4 * NI - 2 * (4 + NI) > 0 ? 4 * NI - 2 * (4 + NI) : 0, 0); __builtin_amdgcn_sched_barrier(0); } while (0)
#define GEMM_MIDBAR() do { asm volatile("s_waitcnt vmcnt(0) lgkmcnt(0)" ::: "memory"); __builtin_amdgcn_s_barrier(); asm volatile("" ::: "memory"); } while (0)
    asm volatile("s_waitcnt vmcnt(0)" ::: "memory");
    __syncthreads();
    GEMM_STAGE(1, 1);
    GEMM_RD(a0, b0, lds, x0);
    for (int kt = 0; kt + 2 < nk; ++kt) {
        const LAS unsigned char* base = lds + (kt & 1) * 32768; const LAS unsigned char* nbase = lds + ((kt + 1) & 1) * 32768;
        GEMM_RD(a1, b1, base, x1);
        GEMM_MM(a0, b0);
        GEMM_SCHED_RD();
        GEMM_MIDBAR();
        GEMM_STAGE(kt & 1, kt + 2);
        GEMM_RD(a0, b0, nbase, x0);
        GEMM_MM(a1, b1);
        GEMM_SCHED_VM_RD();
    }
    {
        GEMM_RD(a1, b1, lds, x1);
        GEMM_MM(a0, b0);
        GEMM_SCHED_RD();
        GEMM_MIDBAR();
        if (nA != nullptr) {
            const char* ga_ = uniform_ptr((const char*)nA); const char* gb_ = uniform_ptr((const char*)nBt);
            LAS unsigned char* la_ = lds + wave * 4096; LAS unsigned char* lb_ = lds + 16384 + wave * (NI * 1024);
#pragma unroll
            for (int i_ = 0; i_ < 4; ++i_) {
                const int r0_ = 32 * wave + 8 * i_ + srow, rb_ = 8 * NI * wave + 8 * i_ + srow; const int r_ = nperm ? perm64(r0_) : r0_;
                __builtin_amdgcn_global_load_lds((const unsigned*)(ga_ + (unsigned)(r_ * nlda + sch * 8) * 2u), (LAS unsigned*)(la_ + i_ * 1024), 16, 0, 0);
                if (i_ < NI) __builtin_amdgcn_global_load_lds((const unsigned*)(gb_ + (unsigned)(rb_ * nldb + sch * 8) * 2u), (LAS unsigned*)(lb_ + i_ * 1024), 16, 0, 0);
            }
        }
        GEMM_RD(a0, b0, lds + 32768, x0);
        GEMM_MM(a1, b1);
        GEMM_SCHED_RD();
    }
    {
        GEMM_RD(a1, b1, lds + 32768, x1);
        GEMM_MM(a0, b0);
        GEMM_SCHED_RD();
        GEMM_MM(a1, b1);
    }
#undef GEMM_RD
#undef GEMM_MM
#undef GEMM_SCHED_RD
#undef GEMM_SCHED_VM_RD
#undef GEMM_MIDBAR
#undef GEMM_STAGE
}

__device__ __forceinline__ bool tile_sched(int it, int vb, int nM, int nN, int& m, int& n) {
    const int x = vb & 7, j = vb >> 3, nbx = (int)gridDim.x >> 3, mper = nM >> 3;
    int lt = it * nbx + j;
    if (lt >= mper * nN) return false;
    const int nchunk = mper >= 16 ? (mper >> 3) : 1; const int cs = mper / nchunk;
    int ci = lt / (cs * nN); if (ci >= nchunk) ci = nchunk - 1;
    lt -= ci * cs * nN;
    const int csi = ci == nchunk - 1 ? mper - ci * cs : cs;
    n = lt / csi; m = x * mper + ci * cs + (lt - n * csi);
    return true;
}
__device__ __forceinline__ void ph_inproj_fast(const Params& p, int l, unsigned char* ldsg, int vb, int nblk) {
    LAS unsigned char* lds = (LAS unsigned char*)ldsg;
    if (l == 0) prep_tables(ldsg);
    int slot = 0; const int nextra = l == 0 ? PREPB_TOTAL : 0; const int per_tile = 1;
    const bf16_t* XLN = (const bf16_t*)(p.ws + OFF_XLN);
    const bf16_t* WT = (const bf16_t*)(p.ws + OFF_WINT) + (size_t)l * 6656 * 1024;
    const float* bias = (const float*)(p.ws + OFF_BINP) + (size_t)l * 6656;
    bf16_t* PL = (bf16_t*)(p.ws + OFF_PL);
    const int tidx = opq_tid(); const int lane = tidx & 63, wave = tidx >> 6, wr = wave >> 1, wc = wave & 1, fr = lane & 15, fq = lane >> 4;
    const int nctx = l == 0 ? 52 : 6;
    auto sched = [&](int it, int& m_, int& n_, int& kind_) -> bool {
        kind_ = 0;
        if (tile_sched(it, vb, NLAT / 128, 48, m_, n_)) { if (n_ >= 10) n_ += 4; return true; }
        int lt = it * (nblk >> 3) + (vb >> 3) - NLAT / 128 / 8 * 48;
        if (lt < nctx) { m_ = NLAT / 128 + (vb & 7); n_ = l == 0 ? lt : (lt < 4 ? 6 + lt : 14 + lt); return true; }
        lt -= nctx;
        if (lt < 64) { m_ = (vb & 7) * 16 + (lt >> 2); n_ = 10 + (lt & 3); kind_ = 1; return true; }
        return false;
    };
    int m, n, kind; bool have = sched(0, m, n, kind); bool pre = false;
    for (int it = 0; have; ++it) {
        int mn = 0, nn = 0, kindn = 0; const bool have_next = sched(it + 1, mn, nn, kindn);
        const bool chain = have_next && kindn == 0;
        const bool nntr = (nn >= 8 && nn < 14) || nn == 19;
        const bf16_t* nA = chain ? XLN + (size_t)mn * 128 * 1024 : nullptr; const bf16_t* nB = chain ? WT + (size_t)nn * 128 * 1024 : nullptr;
        f32x4 acc[4][4];
        if (kind == 1) {
            const int b = m >> 5, a0 = (m & 31) * 2, n0 = n * 128;
            gemm_tile<false, 4, 1>(acc, XLN + ((size_t)b * 4096 + a0) * 1024, 1024, WT + (size_t)n0 * 1024, 1024, 1024, lds, pre, nA, 1024, nB, 1024, nntr);
#pragma unroll
            for (int ni = 0; ni < 4; ++ni) {
                const int ncol = n0 + wc * 64 + ni * 16 + fr; const float bn = bias[ncol];
                const int c = (ncol - 1280) & 255, part = ncol >= 1536;
                bf16_t* h2 = (bf16_t*)(p.ws + OFF_HT2) + (((size_t)b * 256 + c) * 64 + a0 + wr) * 128 + part * 64 + 16 * fq;
                const uint2 s0 = pk4(acc[0][ni] + bn), s1 = pk4(acc[1][ni] + bn), s2 = pk4(acc[2][ni] + bn), s3 = pk4(acc[3][ni] + bn);
                *(uint4*)h2 = make_uint4(s0.x, s0.y, s1.x, s1.y); *(uint4*)(h2 + 8) = make_uint4(s2.x, s2.y, s3.x, s3.y);
            }
            for (int k = 0; k < per_tile; ++k, ++slot) { const int item = slot * nblk + vb; if (item < nextra) { prep_item_b(p, item, ldsg, 32768); } }
            pre = chain; have = have_next; m = mn; n = nn; kind = kindn;
            continue;
        }
        const int m0 = m * 128, n0 = n * 128;
        const bool lat = m0 < NLAT;
        const bool ntr = (n0 >= 1024 && n0 < 1792) || (n0 >= 2432 && n0 < 2560);
        if (!ntr) {
            f32x4 bv[4];
#pragma unroll
            for (int ni = 0; ni < 4; ++ni) bv[ni] = *(const f32x4*)(bias + n0 + wc * 64 + ni * 16 + 4 * fq);
            gemm_tile<true>(acc, XLN + (size_t)m0 * 1024, 1024, WT + (size_t)n0 * 1024, 1024, 1024, lds, pre, nA, 1024, nB, 1024, nntr);
            int pc, mode;
            if (n0 < 1024) { pc = n0; mode = 0; }
            else if (n0 < 2304) { pc = PL_GQ + (n0 - 1792); mode = 1; }
            else if (n0 < 2432) { pc = PL_GK + (n0 - 2304); mode = 1; }
            else { pc = 0; mode = 2; }
            pc += wc * 64 + 16 * fq;
            float fre[4];
#pragma unroll
            for (int e = 0; e < 4; ++e) fre[e] = exp2f(-(float)(4 * fq + e) * (13.287712379549449f / 16.f));
#pragma unroll
            for (int mi = 0; mi < 4; ++mi) {
                const int row = m0 + wr * 64 + mi * 16 + fr;
                f32x4 v[4];
#pragma unroll
                for (int ni = 0; ni < 4; ++ni) v[ni] = acc[mi][ni] + bv[ni];
                if (mode == 1 && lat) {
                    const int t = row & 4095; const float pr = (float)(t >> 6), pcl = (float)(t & 63);
#pragma unroll
                    for (int e = 0; e < 4; ++e) {
                        float sn, cs; sincos_red(pr * fre[e], sn, cs);
                        const float x1 = v[0][e], x2 = v[1][e]; v[0][e] = x1 * cs - x2 * sn; v[1][e] = x1 * sn + x2 * cs;
                        sincos_red(pcl * fre[e], sn, cs);
                        const float y1 = v[2][e], y2 = v[3][e]; v[2][e] = y1 * cs - y2 * sn; v[3][e] = y1 * sn + y2 * cs;
                    }
                }
                if (mode == 2) {
                    unsigned char* g8 = p.ws + OFF_G8 + (size_t)row * 4096 + (n0 - 2560) + wc * 64 + 16 * fq;
                    u32x4 w4;
#pragma unroll
                    for (int ni = 0; ni < 4; ++ni) {
                        u32 w = 0u;
#pragma unroll
                        for (int e = 0; e < 4; ++e) w = __builtin_amdgcn_cvt_pk_u8_f32(sigmoid_f(v[ni][e]) * 255.f, e, w);
                        w4[ni] = w;
                    }
                    *(u32x4*)g8 = w4;
                } else {
                    const uint2 s0 = pk4(v[0]), s1 = pk4(v[1]), s2 = pk4(v[2]), s3 = pk4(v[3]);
                    *(uint4*)(PL + (size_t)row * PLW + pc) = make_uint4(s0.x, s0.y, s1.x, s1.y); *(uint4*)(PL + (size_t)row * PLW + pc + 8) = make_uint4(s2.x, s2.y, s3.x, s3.y);
                }
            }
        } else {
            gemm_tile<false, 4, 2>(acc, XLN + (size_t)m0 * 1024, 1024, WT + (size_t)n0 * 1024, 1024, 1024, lds, pre, nA, 1024, nB, 1024, nntr);
            const int b = lat ? (m0 >> 12) : ((m0 - NLAT) >> 8);
            const int tb = (lat ? (m0 & 4095) : ((m0 - NLAT) & 255)) + wr * 64 + 16 * fq;
#pragma unroll
            for (int ni = 0; ni < 4; ++ni) {
                const int ncol = n0 + wc * 64 + ni * 16 + fr; const float bn = bias[ncol];
                bf16_t* dst;
                if (ncol < 1280) { const int c = perm64(ncol - 1024); dst = lat ? (bf16_t*)(p.ws + OFF_NVT) + ((size_t)b * 256 + c) * 4096 : (bf16_t*)(p.ws + OFF_NVTC) + ((size_t)b * 256 + c) * 256; }
                else if (ncol < 1536) { const int c = ncol - 1280; dst = lat ? (bf16_t*)(p.ws + OFF_HT) + ((size_t)b * 256 + c) * 8192 : (bf16_t*)(p.ws + OFF_HTC) + ((size_t)b * 256 + c) * 512; }
                else if (ncol < 1792) { const int c = ncol - 1536; dst = lat ? (bf16_t*)(p.ws + OFF_HT) + ((size_t)b * 256 + c) * 8192 + 4096 : (bf16_t*)(p.ws + OFF_HTC) + ((size_t)b * 256 + c) * 512 + 256; }
                else { const int c = perm64(ncol - 2432); dst = lat ? (bf16_t*)(p.ws + OFF_GVT) + ((size_t)b * 128 + c) * 4096 : (bf16_t*)(p.ws + OFF_GVTC) + ((size_t)b * 128 + c) * 256; }
                const uint2 s0 = pk4(acc[0][ni] + bn), s1 = pk4(acc[1][ni] + bn), s2 = pk4(acc[2][ni] + bn), s3 = pk4(acc[3][ni] + bn);
                *(uint4*)(dst + tb) = make_uint4(s0.x, s0.y, s1.x, s1.y); *(uint4*)(dst + tb + 8) = make_uint4(s2.x, s2.y, s3.x, s3.y);
            }
        }
        for (int k = 0; k < per_tile; ++k, ++slot) { const int item = slot * nblk + vb; if (item < nextra) { prep_item_b(p, item, ldsg, 32768); } }
        pre = chain; have = have_next; m = mn; n = nn; kind = kindn;
    }
    for (; slot * nblk + vb < nextra; ++slot) { const int item = slot * nblk + vb; prep_item_b(p, item, ldsg, 32768); }
}


#define CTL_EUVQ 4400
__device__ __forceinline__ void euv_queue_work(const Params& p, volatile LAS unsigned* misc, int quota) {
    unsigned* ctr = (unsigned*)(p.ws + OFF_CTL) + CTL_EUVQ;
    for (int k = 0; k < quota; k += 8) {
        __syncthreads();
        if (opq_tid() == 0) misc[6] = __hip_atomic_fetch_add(ctr, 8u, __ATOMIC_RELAXED, __HIP_MEMORY_SCOPE_AGENT);
        __syncthreads();
        const int it0 = (int)misc[6];
        if (it0 >= 8192) break;
        for (int q = 0; q < 8; ++q) prep_euv_item(p, (it0 + q) >> 12, (it0 + q) & 4095);
    }
}
__device__ __forceinline__ void ph_merge_fast(const Params& p, int l, int nrows, LAS unsigned char* lds, int vb) {
    const bf16_t* Y = (const bf16_t*)(p.ws + OFF_Y); const unsigned char* G8 = p.ws + OFF_G8; bf16_t* M = (bf16_t*)(p.ws + OFF_M);
    const bf16_t* WB = (const bf16_t*)(p.ws + OFF_WBRT) + (size_t)l * WBRT_L;
    const int tidx = opq_tid(); const int lane = tidx & 63, wave = tidx >> 6, wr = wave >> 1, wc = wave & 1, fr = lane & 15, fq = lane >> 4;
    int m, n; bool have = tile_sched(0, vb, nrows / 128, 8, m, n); bool pre = false;
    for (int it = 0; have; ++it) {
        int mn, nn; const bool have_next = tile_sched(it + 1, vb, nrows / 128, 8, mn, nn);
        const int m0 = m * 128, n0 = n * 128;
        f32x4 macc[4][4];
#pragma unroll
        for (int mi = 0; mi < 4; ++mi)
#pragma unroll
            for (int ni = 0; ni < 4; ++ni) macc[mi][ni] = (f32x4){0.f, 0.f, 0.f, 0.f};
#pragma unroll 1
        for (int br = 0; br < 4; ++br) {
            const int K = br < 3 ? 256 : 512;
            f32x4 acc[4][4];
            const bf16_t* nA; const bf16_t* nB; int nK;
            if (br < 3) { nK = br < 2 ? 256 : 512; nA = Y + (size_t)m0 * YW + (br + 1) * 256; nB = WB + (size_t)(br + 1) * 1024 * 256 + (size_t)n0 * nK; }
            else { nK = 256; nA = have_next ? Y + (size_t)mn * 128 * YW : nullptr; nB = have_next ? WB + (size_t)nn * 128 * 256 : nullptr; }
            gemm_tile<true>(acc, Y + (size_t)m0 * YW + br * 256, YW, WB + (size_t)br * 1024 * 256 + (size_t)n0 * K, K, K, lds, pre, nA, YW, nB, nK);
            pre = (nA != nullptr);
            u32x4 gq[4];
#pragma unroll
            for (int mi = 0; mi < 4; ++mi) gq[mi] = *(const u32x4*)(G8 + (size_t)(m0 + wr * 64 + mi * 16 + fr) * 4096 + br * 1024 + n0 + wc * 64 + 16 * fq);
            asm volatile("" : "+v"(gq[0]), "+v"(gq[1]), "+v"(gq[2]), "+v"(gq[3]));
#pragma unroll
            for (int mi = 0; mi < 4; ++mi) {
                const u32x4 g4 = gq[mi];
#pragma unroll
                for (int ni = 0; ni < 4; ++ni) {
                    const u32 g = g4[ni];
                    macc[mi][ni][0] += (float)(g & 255u) * acc[mi][ni][0]; macc[mi][ni][1] += (float)((g >> 8) & 255u) * acc[mi][ni][1];
                    macc[mi][ni][2] += (float)((g >> 16) & 255u) * acc[mi][ni][2]; macc[mi][ni][3] += (float)(g >> 24) * acc[mi][ni][3];
                }
                asm volatile("" ::: "memory");
            }
        }
#pragma unroll
        for (int mi = 0; mi < 4; ++mi) {
            const int row = m0 + wr * 64 + mi * 16 + fr;
            const uint2 s0 = pk4(macc[mi][0] * (1.f / 255.f)), s1 = pk4(macc[mi][1] * (1.f / 255.f)), s2 = pk4(macc[mi][2] * (1.f / 255.f)), s3 = pk4(macc[mi][3] * (1.f / 255.f));
            bf16_t* mo = M + (size_t)row * 1024 + n0 + wc * 64 + 16 * fq;
            *(uint4*)mo = make_uint4(s0.x, s0.y, s1.x, s1.y); *(uint4*)(mo + 8) = make_uint4(s2.x, s2.y, s3.x, s3.y);
        }
        have = have_next; m = mn; n = nn;
    }
}

__device__ __forceinline__ void ph_wout_fast(const Params& p, int l, int nrows, const float* xlat, const float* xctx, LAS unsigned char* lds, int vb) {
    const bf16_t* M = (const bf16_t*)(p.ws + OFF_M); bf16_t* Z = (bf16_t*)(p.ws + OFF_Z);
    const bf16_t* WT = (const bf16_t*)(p.ws + OFF_WOT) + (size_t)l * 1024 * 1024;
    const float* mods = (const float*)(p.ws + OFF_MODS) + (size_t)l * 5 * 6144;
    const int tidx = opq_tid(); const int lane = tidx & 63, wave = tidx >> 6, wr = wave >> 1, wc = wave & 1, fr = lane & 15, fq = lane >> 4;
    int m, n; bool have = tile_sched(0, vb, nrows / 128, 8, m, n); bool pre = false;
    for (int it = 0; have; ++it) {
        int mn, nn; const bool have_next = tile_sched(it + 1, vb, nrows / 128, 8, mn, nn);
        const int m0 = m * 128, n0 = n * 128;
        f32x4 acc[4][4];
        const float* g1 = mods + (size_t)row_mod(m0) * 6144 + 2048;
        const int col = n0 + wc * 64 + 16 * fq;
        f32x4 gv[4];
#pragma unroll
        for (int ni = 0; ni < 4; ++ni) gv[ni] = *(const f32x4*)(g1 + col + 4 * ni);
        gemm_tile<true>(acc, M + (size_t)m0 * 1024, 1024, WT + (size_t)n0 * 1024, 1024, 1024, lds, pre,
                        have_next ? M + (size_t)mn * 128 * 1024 : nullptr, 1024, have_next ? WT + (size_t)nn * 128 * 1024 : nullptr, 1024);
        pre = have_next; have = have_next; m = mn; n = nn;
        f32x4 xv[4][4];
#pragma unroll
        for (int mi = 0; mi < 4; ++mi) {
            const int row = m0 + wr * 64 + mi * 16 + fr;
            const float* xr = row < NLAT ? xlat + (size_t)row * 1024 : xctx + (size_t)(row - NLAT) * 1024;
#pragma unroll
            for (int ni = 0; ni < 4; ++ni) xv[mi][ni] = *(const f32x4*)(xr + col + 4 * ni);
        }
#pragma unroll
        for (int mi = 0; mi < 4; ++mi) asm volatile("" : "+v"(xv[mi][0]), "+v"(xv[mi][1]), "+v"(xv[mi][2]), "+v"(xv[mi][3]));
#pragma unroll
        for (int mi = 0; mi < 4; ++mi) {
            const int row = m0 + wr * 64 + mi * 16 + fr;
            uint2 sz[4];
#pragma unroll
            for (int ni = 0; ni < 4; ++ni) sz[ni] = pk4(ALPHA * xv[mi][ni] + gv[ni] * acc[mi][ni]);
            *(uint4*)(Z + (size_t)row * 1024 + col) = make_uint4(sz[0].x, sz[0].y, sz[1].x, sz[1].y); *(uint4*)(Z + (size_t)row * 1024 + col + 8) = make_uint4(sz[2].x, sz[2].y, sz[3].x, sz[3].y);
        }
    }
}


__device__ __forceinline__ void attn_stage(LAS unsigned char* lds, int s, const bf16_t* Kp, int kstride, const bf16_t* Vp, int vstride, int wave, int lane) {
    const int sr = lane >> 3;
#pragma unroll
    for (int i = 0; i < 2; ++i) {
        const int j = 2 * wave + i; const int r = 8 * j + sr;
        const int ck = (lane & 7) ^ sr, cv = (lane & 7) ^ ((r >> 1) & 7);
        __builtin_amdgcn_global_load_lds((const unsigned*)(Kp + (size_t)r * kstride + ck * 8), (LAS unsigned*)(lds + s * 16384 + j * 1024), 16, 0, 0);
        __builtin_amdgcn_global_load_lds((const unsigned*)(Vp + (size_t)r * vstride + cv * 8), (LAS unsigned*)(lds + s * 16384 + 8192 + j * 1024), 16, 0, 0);
    }
}
template <int MODE>
__device__ __forceinline__ void attn_item(const Params& p, int l, int item, bool gqa, LAS unsigned char* lds) {
    const int tid = opq_tid(), lane = tid & 63, fr = lane & 15, fq = lane >> 4;
    const int wave = __builtin_amdgcn_readfirstlane(tid >> 6);
    const bf16_t* PL = (const bf16_t*)(p.ws + OFF_PL); bf16_t* Y = (bf16_t*)(p.ws + OFF_Y);
    int b, qrow0, qcol, kcol, ycol, vrow; float sink = 0.f; bool has_sink = false;
    int rstart = 0, rr = 0, t0 = 0, nch = 4, jlo = 0;
    if (MODE == 0) {
        if (!gqa) { const int qb = item & 3, h = (item >> 2) & 3; b = item >> 4; qrow0 = NLAT + b * 256 + qb * 64; qcol = PL_NQ + h * 64; kcol = PL_NK + h * 64; ycol = 256 + h * 64; vrow = b * 256 + h * 64; }
        else { const int qb = item & 3, hq = (item >> 2) & 7; b = item >> 5; qrow0 = NLAT + b * 256 + qb * 64; qcol = PL_GQ + hq * 64; kcol = PL_GK + (hq >> 2) * 64; ycol = 768 + hq * 64; vrow = b * 128 + (hq >> 2) * 64;
               sink = p.in[13][l * 8 + hq]; has_sink = true; }
    } else if (MODE == 1) {
        const int h = item & 3; rr = (item >> 2) & 63; b = item >> 8; qrow0 = b * 4096 + rr * 64; qcol = PL_NQ + h * 64; kcol = PL_NK + h * 64; ycol = 256 + h * 64; vrow = b * 256 + h * 64;
        rstart = min(max(rr - 4, 0), 56); nch = 12;
        const float* rp = p.in[12] + (size_t)(l * 4 + h) * 465; float* rs = (float*)((unsigned char*)lds + 65536);
        __syncthreads();
        for (int i = tid; i < 465; i += NTHREADS) rs[i] = rp[i] * 1.4426950409f;
    } else {
        const int hq = item & 7; const int tb = (item >> 3) & 63; b = item >> 9; t0 = tb * 64; qrow0 = b * 4096 + t0; qcol = PL_GQ + hq * 64; kcol = PL_GK + (hq >> 2) * 64; ycol = 768 + hq * 64; vrow = b * 128 + (hq >> 2) * 64;
        sink = p.in[13][l * 8 + hq]; has_sink = true;
        jlo = t0 == 0 ? 2 : (t0 == 64 ? 1 : 0); const int jhi = t0 == 4032 ? 2 : (t0 == 3968 ? 3 : 4);
        nch = 4 + (jhi - jlo + 1);
    }
    const bf16_t* VTC = (const bf16_t*)(p.ws + (gqa ? OFF_GVTC : OFF_NVTC)) + (size_t)vrow * 256;
    const bf16_t* VTL = (const bf16_t*)(p.ws + (gqa ? OFF_GVT : OFF_NVT)) + (size_t)vrow * 4096;
    const bf16_t* KC = PL + (size_t)(NLAT + b * 256) * PLW + kcol;
    const bf16_t* KL = PL + (size_t)(b * 4096) * PLW + kcol;
#define ATT_PTRS(c, Kp, Vp, vs) do { if ((c) < 4) { Kp = KC + (size_t)(c) * 64 * PLW; Vp = VTC + (c) * 64; vs = 256; } \
        else { const int key0_ = MODE == 1 ? (rstart + (c) - 4) * 64 : t0 - 128 + 64 * ((c) - 4 + jlo); Kp = KL + (size_t)key0_ * PLW; Vp = VTL + key0_; vs = 4096; } } while (0)
    const int qrow = qrow0 + 16 * wave + fr;
    const bf16_t* qp = PL + (size_t)qrow * PLW + qcol + 8 * fq;
    bf16x8 q0 = *(const bf16x8*)qp, q1 = *(const bf16x8*)(qp + 32);
    float m = -1e30f, lsum = 0.f;
    f32x4 o[4];
#pragma unroll
    for (int dt = 0; dt < 4; ++dt) o[dt] = (f32x4){0.f, 0.f, 0.f, 0.f};
    const int cq = 16 * wave + fr;
    const int cst = min(max(cq - 8, 0), 48);
    const int klo = min(max(16 * wave - 8, 0), 48) >> 4, khi = (min(max(16 * wave + 7, 0), 48) + 15) >> 4;
    asm volatile("" : "+v"(q0), "+v"(q1), "+v"(sink));
    __syncthreads();
#pragma unroll
    for (int c0 = 0; c0 < 3; ++c0) { const bf16_t* Kp; const bf16_t* Vp; int vs; ATT_PTRS(c0, Kp, Vp, vs); attn_stage(lds, c0, Kp, PLW, Vp, vs, wave, lane); }
    for (int c = 0; c < nch; ++c) {
        if (c + 2 < nch) asm volatile("s_waitcnt vmcnt(8)" ::: "memory");
        else if (c + 1 < nch) asm volatile("s_waitcnt vmcnt(4)" ::: "memory");
        else asm volatile("s_waitcnt vmcnt(0)" ::: "memory");
        asm volatile("s_waitcnt lgkmcnt(0)" ::: "memory");
        __builtin_amdgcn_s_barrier();
        asm volatile("" ::: "memory");
        if (c + 3 < nch) { const bf16_t* Kp; const bf16_t* Vp; int vs; ATT_PTRS(c + 3, Kp, Vp, vs); attn_stage(lds, (c + 3) & 3, Kp, PLW, Vp, vs, wave, lane); }
        const LAS unsigned char* Kb = lds + (c & 3) * 16384; const LAS unsigned char* Vb = Kb + 8192;
        const bool band = c >= 4;
        f32x4 sa[4]; bool on[4];
        float pm = -1e30f;
#pragma unroll
        for (int kt = 0; kt < 4; ++kt) {
            on[kt] = !(MODE == 1 && band) || (kt >= klo && kt <= khi);
            sa[kt] = (f32x4){0.f, 0.f, 0.f, 0.f};
            if (on[kt]) {
                const bf16x8 k0 = *(const LAS bf16x8*)(Kb + (16 * kt + fr) * 128 + (((0 + fq) ^ (fr & 7)) << 4));
                const bf16x8 k1 = *(const LAS bf16x8*)(Kb + (16 * kt + fr) * 128 + (((4 + fq) ^ (fr & 7)) << 4));
                sa[kt] = __builtin_amdgcn_mfma_f32_16x16x32_bf16(k0, q0, sa[kt], 0, 0, 0);
                sa[kt] = __builtin_amdgcn_mfma_f32_16x16x32_bf16(k1, q1, sa[kt], 0, 0, 0);
            }
        }
        if (MODE == 1 && band) {
            const float* rs = (const float*)((const unsigned char*)lds + 65536) + (rstart + (c - 4) - rr + 7) * 31 + (15 - cq);
#pragma unroll
            for (int kt = 0; kt < 4; ++kt) if (on[kt]) {
#pragma unroll
                for (int e = 0; e < 4; ++e) {
                    const int kk = 16 * kt + 4 * fq + e; const bool valid = (unsigned)(kk - cst) < 16u;
                    const float bias = rs[valid ? kk : cq];
                    const float sv = valid ? sa[kt][e] * 0.18033688f + bias : -1e30f;
                    sa[kt][e] = sv; pm = fmaxf(pm, sv);
                }
            }
        } else if (MODE == 2 && band && (c - 4 + jlo == 0 || c - 4 + jlo == 4)) {
            const int d0 = -128 + 64 * (c - 4 + jlo) - cq;
#pragma unroll
            for (int kt = 0; kt < 4; ++kt)
#pragma unroll
                for (int e = 0; e < 4; ++e) {
                    const int dlt = d0 + 16 * kt + 4 * fq + e; const bool valid = dlt >= -128 && dlt <= 128;
                    const float sv = valid ? sa[kt][e] * 0.18033688f : -1e30f;
                    sa[kt][e] = sv; pm = fmaxf(pm, sv);
                }
        } else {
#pragma unroll
            for (int kt = 0; kt < 4; ++kt)
#pragma unroll
                for (int e = 0; e < 4; ++e) { const float sv = sa[kt][e] * 0.18033688f; sa[kt][e] = sv; pm = fmaxf(pm, sv); }
        }
        pm = xmax32(xmax16(pm));
        const float mn = fmaxf(m, pm); const float alpha = __builtin_amdgcn_exp2f(m - mn); m = mn;
        float ps = 0.f;
#pragma unroll
        for (int kt = 0; kt < 4; ++kt) {
            if (on[kt]) {
#pragma unroll
                for (int e = 0; e < 4; ++e) { const float pv = __builtin_amdgcn_exp2f(sa[kt][e] - mn); sa[kt][e] = pv; ps += pv; }
            }
        }
        lsum = lsum * alpha + ps;
#pragma unroll
        for (int dt = 0; dt < 4; ++dt) o[dt] *= alpha;
#pragma unroll
        for (int s2 = 0; s2 < 2; ++s2) {
            if (!(on[2 * s2] || on[2 * s2 + 1])) continue;
            union { uint4 u; bf16x8 v; } pf;
            pf.u.x = pk2(sa[2 * s2][0], sa[2 * s2][1]); pf.u.y = pk2(sa[2 * s2][2], sa[2 * s2][3]);
            pf.u.z = pk2(sa[2 * s2 + 1][0], sa[2 * s2 + 1][1]); pf.u.w = pk2(sa[2 * s2 + 1][2], sa[2 * s2 + 1][3]);
            const int sw = (fr >> 1) & 7;
            const int a0 = (((4 * s2 + (fq >> 1)) ^ sw) << 4) + (fq & 1) * 8, a1 = (((4 * s2 + 2 + (fq >> 1)) ^ sw) << 4) + (fq & 1) * 8;
#pragma unroll
            for (int dt = 0; dt < 4; ++dt) {
                union { uint4 u; bf16x8 v; } vf;
                const u32x2 lo = *(const LAS u32x2*)(Vb + (16 * dt + fr) * 128 + a0), hi = *(const LAS u32x2*)(Vb + (16 * dt + fr) * 128 + a1);
                vf.u.x = lo[0]; vf.u.y = lo[1]; vf.u.z = hi[0]; vf.u.w = hi[1];
                o[dt] = __builtin_amdgcn_mfma_f32_16x16x32_bf16(vf.v, pf.v, o[dt], 0, 0, 0);
            }
        }
    }
#undef ATT_PTRS
    float lt = xsum32(xsum16(lsum));
    if (has_sink) lt += __builtin_amdgcn_exp2f(sink * 1.4426950409f - m);
    const float inv = 1.f / lt;
#pragma unroll
    for (int dt = 0; dt < 4; ++dt) o[dt] *= inv;
    {
        const uint2 s0 = pk4(o[0]), s1 = pk4(o[1]), s2 = pk4(o[2]), s3 = pk4(o[3]);
        bf16_t* yo = Y + (size_t)qrow * YW + ycol + 16 * fq;
        *(uint4*)yo = make_uint4(s0.x, s0.y, s1.x, s1.y); *(uint4*)(yo + 8) = make_uint4(s2.x, s2.y, s3.x, s3.y);
    }
}

__device__ __forceinline__ void attn_gqa4(const Params& p, int l, int item, LAS unsigned char* lds) {
    const int tid = opq_tid(), lane = tid & 63, fr = lane & 15, fq = lane >> 4;
    const int wave = __builtin_amdgcn_readfirstlane(tid >> 6);
    const bf16_t* PL = (const bf16_t*)(p.ws + OFF_PL); bf16_t* Y = (bf16_t*)(p.ws + OFF_Y);
    const int kvh = item & 1, tb = (item >> 1) & 63, b = item >> 7;
    const int t0 = tb * 64, qrow0 = b * 4096 + t0, kcol = PL_GK + kvh * 64, vrow = b * 128 + kvh * 64;
    const int jlo = t0 == 0 ? 2 : (t0 == 64 ? 1 : 0); const int jhi = t0 == 4032 ? 2 : (t0 == 3968 ? 3 : 4);
    const int nch = 4 + (jhi - jlo + 1);
    const bf16_t* VTC = (const bf16_t*)(p.ws + OFF_GVTC) + (size_t)vrow * 256;
    const bf16_t* VTL = (const bf16_t*)(p.ws + OFF_GVT) + (size_t)vrow * 4096;
    const bf16_t* KC = PL + (size_t)(NLAT + b * 256) * PLW + kcol;
    const bf16_t* KL = PL + (size_t)(b * 4096) * PLW + kcol;
#define ATT_PTRS(c, Kp, Vp, vs) do { if ((c) < 4) { Kp = KC + (size_t)(c) * 64 * PLW; Vp = VTC + (c) * 64; vs = 256; } \
        else { const int key0_ = t0 - 128 + 64 * ((c) - 4 + jlo); Kp = KL + (size_t)key0_ * PLW; Vp = VTL + key0_; vs = 4096; } } while (0)
    const int qrow = qrow0 + 16 * wave + fr;
    bf16x8 q0[4], q1[4]; float sink[4], m[4], lsum[4];
    f32x4 o[4][4];
#pragma unroll
    for (int hh = 0; hh < 4; ++hh) {
        const bf16_t* qp = PL + (size_t)qrow * PLW + PL_GQ + (kvh * 4 + hh) * 64 + 8 * fq;
        q0[hh] = *(const bf16x8*)qp; q1[hh] = *(const bf16x8*)(qp + 32);
        sink[hh] = p.in[13][l * 8 + kvh * 4 + hh]; m[hh] = -1e30f; lsum[hh] = 0.f;
#pragma unroll
        for (int dt = 0; dt < 4; ++dt) o[hh][dt] = (f32x4){0.f, 0.f, 0.f, 0.f};
    }
    const int cq = 16 * wave + fr;
#pragma unroll
    for (int hh = 0; hh < 4; ++hh) asm volatile("" : "+v"(q0[hh]), "+v"(q1[hh]), "+v"(sink[hh]));
    __syncthreads();
#pragma unroll
    for (int c0 = 0; c0 < 3; ++c0) { const bf16_t* Kp; const bf16_t* Vp; int vs; ATT_PTRS(c0, Kp, Vp, vs); attn_stage(lds, c0, Kp, PLW, Vp, vs, wave, lane); }
    for (int c = 0; c < nch; ++c) {
        if (c + 2 < nch) asm volatile("s_waitcnt vmcnt(8)" ::: "memory");
        else if (c + 1 < nch) asm volatile("s_waitcnt vmcnt(4)" ::: "memory");
        else asm volatile("s_waitcnt vmcnt(0)" ::: "memory");
        asm volatile("s_waitcnt lgkmcnt(0)" ::: "memory");
        __builtin_amdgcn_s_barrier();
        asm volatile("" ::: "memory");
        if (c + 3 < nch) { const bf16_t* Kp; const bf16_t* Vp; int vs; ATT_PTRS(c + 3, Kp, Vp, vs); attn_stage(lds, (c + 3) & 3, Kp, PLW, Vp, vs, wave, lane); }
        const LAS unsigned char* Kb = lds + (c & 3) * 16384; const LAS unsigned char* Vb = Kb + 8192;
        const bool edge = c >= 4 && (c - 4 + jlo == 0 || c - 4 + jlo == 4);
        const int d0 = -128 + 64 * (c - 4 + jlo) - cq;
#pragma unroll
        for (int hp = 0; hp < 2; ++hp) {
        uint4 pf[2][2];
        {
#pragma unroll
            for (int h2 = 0; h2 < 2; ++h2) { const int hh = 2 * hp + h2;
                f32x4 sa[4]; float pm = -1e30f;
#pragma unroll
                for (int kt = 0; kt < 4; ++kt) {
                    const bf16x8 k0 = *(const LAS bf16x8*)(Kb + (16 * kt + fr) * 128 + (((0 + fq) ^ (fr & 7)) << 4));
                    const bf16x8 k1 = *(const LAS bf16x8*)(Kb + (16 * kt + fr) * 128 + (((4 + fq) ^ (fr & 7)) << 4));
                    sa[kt] = __builtin_amdgcn_mfma_f32_16x16x32_bf16(k0, q0[hh], (f32x4){0.f, 0.f, 0.f, 0.f}, 0, 0, 0);
                    sa[kt] = __builtin_amdgcn_mfma_f32_16x16x32_bf16(k1, q1[hh], sa[kt], 0, 0, 0);
                }
                asm volatile("" ::: "memory");
                if (edge) {
#pragma unroll
                    for (int kt = 0; kt < 4; ++kt)
#pragma unroll
                        for (int e = 0; e < 4; ++e) {
                            const int dlt = d0 + 16 * kt + 4 * fq + e; const bool valid = dlt >= -128 && dlt <= 128;
                            const float sv = valid ? sa[kt][e] * 0.18033688f : -1e30f;
                            sa[kt][e] = sv; pm = fmaxf(pm, sv);
                        }
                } else {
#pragma unroll
                    for (int kt = 0; kt < 4; ++kt)
#pragma unroll
                        for (int e = 0; e < 4; ++e) { const float sv = sa[kt][e] * 0.18033688f; sa[kt][e] = sv; pm = fmaxf(pm, sv); }
                }
                pm = xmax32(xmax16(pm));
                const float mn = fmaxf(m[hh], pm); const float alpha = __builtin_amdgcn_exp2f(m[hh] - mn); m[hh] = mn;
                float ps = 0.f;
#pragma unroll
                for (int kt = 0; kt < 4; ++kt)
#pragma unroll
                    for (int e = 0; e < 4; ++e) { const float pv = __builtin_amdgcn_exp2f(sa[kt][e] - mn); sa[kt][e] = pv; ps += pv; }
                lsum[hh] = lsum[hh] * alpha + ps;
#pragma unroll
                for (int dt = 0; dt < 4; ++dt) o[hh][dt] *= alpha;
#pragma unroll
                for (int s2 = 0; s2 < 2; ++s2)
                    pf[h2][s2] = make_uint4(pk2(sa[2 * s2][0], sa[2 * s2][1]), pk2(sa[2 * s2][2], sa[2 * s2][3]), pk2(sa[2 * s2 + 1][0], sa[2 * s2 + 1][1]), pk2(sa[2 * s2 + 1][2], sa[2 * s2 + 1][3]));
            }
        }
#pragma unroll
        for (int s2 = 0; s2 < 2; ++s2) {
            const int sw = (fr >> 1) & 7;
            const int a0 = (((4 * s2 + (fq >> 1)) ^ sw) << 4) + (fq & 1) * 8, a1 = (((4 * s2 + 2 + (fq >> 1)) ^ sw) << 4) + (fq & 1) * 8;
#pragma unroll
            for (int dt = 0; dt < 4; ++dt) {
                union { uint4 u; bf16x8 v; } vf;
                const u32x2 lo = *(const LAS u32x2*)(Vb + (16 * dt + fr) * 128 + a0), hi = *(const LAS u32x2*)(Vb + (16 * dt + fr) * 128 + a1);
                vf.u.x = lo[0]; vf.u.y = lo[1]; vf.u.z = hi[0]; vf.u.w = hi[1];
#pragma unroll
                for (int h2 = 0; h2 < 2; ++h2) { union { uint4 u; bf16x8 v; } pq; pq.u = pf[h2][s2]; o[2 * hp + h2][dt] = __builtin_amdgcn_mfma_f32_16x16x32_bf16(vf.v, pq.v, o[2 * hp + h2][dt], 0, 0, 0); }
            }
        }
        asm volatile("" ::: "memory");
        }
    }
#undef ATT_PTRS
#pragma unroll
    for (int hh = 0; hh < 4; ++hh) {
        float lt = xsum32(xsum16(lsum[hh]));
        lt += __builtin_amdgcn_exp2f(sink[hh] * 1.4426950409f - m[hh]);
        const float inv = 1.f / lt;
#pragma unroll
        for (int dt = 0; dt < 4; ++dt) o[hh][dt] *= inv;
        const uint2 s0 = pk4(o[hh][0]), s1 = pk4(o[hh][1]), s2 = pk4(o[hh][2]), s3 = pk4(o[hh][3]);
        bf16_t* yo = Y + (size_t)qrow * YW + 768 + (kvh * 4 + hh) * 64 + 16 * fq;
        *(uint4*)yo = make_uint4(s0.x, s0.y, s1.x, s1.y); *(uint4*)(yo + 8) = make_uint4(s2.x, s2.y, s3.x, s3.y);
    }
}

__device__ __forceinline__ void attn_nat2(const Params& p, int l, int item, LAS unsigned char* lds) {
    const int tid = opq_tid(), lane = tid & 63, fr = lane & 15, fq = lane >> 4;
    const int wave = __builtin_amdgcn_readfirstlane(tid >> 6);
    const bf16_t* PL = (const bf16_t*)(p.ws + OFF_PL); bf16_t* Y = (bf16_t*)(p.ws + OFF_Y);
    const int h = item & 3, jp = (item >> 2) & 31, b = item >> 7;
    const int rrA = 2 * jp, rsA = min(max(rrA - 4, 0), 56), rsB = min(max(rrA - 3, 0), 56);
    const int nch = 4 + (rsB + 8 - rsA);
    const int qcol = PL_NQ + h * 64, kcol = PL_NK + h * 64, vrow = b * 256 + h * 64;
    {
        const float* rp = p.in[12] + (size_t)(l * 4 + h) * 465; float* rs = (float*)((unsigned char*)lds + 65536);
        __syncthreads();
        for (int i = tid; i < 465; i += NTHREADS) rs[i] = rp[i] * 1.4426950409f;
    }
    const bf16_t* VTC = (const bf16_t*)(p.ws + OFF_NVTC) + (size_t)vrow * 256;
    const bf16_t* VTL = (const bf16_t*)(p.ws + OFF_NVT) + (size_t)vrow * 4096;
    const bf16_t* KC = PL + (size_t)(NLAT + b * 256) * PLW + kcol;
    const bf16_t* KL = PL + (size_t)(b * 4096) * PLW + kcol;
#define ATT_PTRS(c, Kp, Vp, vs) do { if ((c) < 4) { Kp = KC + (size_t)(c) * 64 * PLW; Vp = VTC + (c) * 64; vs = 256; } \
        else { const int key0_ = (rsA + (c) - 4) * 64; Kp = KL + (size_t)key0_ * PLW; Vp = VTL + key0_; vs = 4096; } } while (0)
    const int cq = 16 * wave + fr;
    bf16x8 q0[2], q1[2]; float m[2], lsum[2];
    f32x4 o[2][4];
#pragma unroll
    for (int g = 0; g < 2; ++g) {
        const bf16_t* qp = PL + (size_t)(b * 4096 + (rrA + g) * 64 + cq) * PLW + qcol + 8 * fq;
        q0[g] = *(const bf16x8*)qp; q1[g] = *(const bf16x8*)(qp + 32); m[g] = -1e30f; lsum[g] = 0.f;
#pragma unroll
        for (int dt = 0; dt < 4; ++dt) o[g][dt] = (f32x4){0.f, 0.f, 0.f, 0.f};
    }
    const int cst = min(max(cq - 8, 0), 48);
    const int klo = min(max(16 * wave - 8, 0), 48) >> 4, khi = (min(max(16 * wave + 7, 0), 48) + 15) >> 4;
#pragma unroll
    for (int g = 0; g < 2; ++g) asm volatile("" : "+v"(q0[g]), "+v"(q1[g]));
    __syncthreads();
#pragma unroll
    for (int c0 = 0; c0 < 3; ++c0) { const bf16_t* Kp; const bf16_t* Vp; int vs; ATT_PTRS(c0, Kp, Vp, vs); attn_stage(lds, c0, Kp, PLW, Vp, vs, wave, lane); }
    for (int c = 0; c < nch; ++c) {
        if (c + 2 < nch) asm volatile("s_waitcnt vmcnt(8)" ::: "memory");
        else if (c + 1 < nch) asm volatile("s_waitcnt vmcnt(4)" ::: "memory");
        else asm volatile("s_waitcnt vmcnt(0)" ::: "memory");
        asm volatile("s_waitcnt lgkmcnt(0)" ::: "memory");
        __builtin_amdgcn_s_barrier();
        asm volatile("" ::: "memory");
        if (c + 3 < nch) { const bf16_t* Kp; const bf16_t* Vp; int vs; ATT_PTRS(c + 3, Kp, Vp, vs); attn_stage(lds, (c + 3) & 3, Kp, PLW, Vp, vs, wave, lane); }
        const LAS unsigned char* Kb = lds + (c & 3) * 16384; const LAS unsigned char* Vb = Kb + 8192;
        const bool band = c >= 4;
        const int kr = rsA + c - 4;
        bool on[4];
#pragma unroll
        for (int kt = 0; kt < 4; ++kt) on[kt] = !band || (kt >= klo && kt <= khi);
        bf16x8 k0[4], k1[4];
#pragma unroll
        for (int kt = 0; kt < 4; ++kt) if (on[kt]) {
            k0[kt] = *(const LAS bf16x8*)(Kb + (16 * kt + fr) * 128 + (((0 + fq) ^ (fr & 7)) << 4));
            k1[kt] = *(const LAS bf16x8*)(Kb + (16 * kt + fr) * 128 + (((4 + fq) ^ (fr & 7)) << 4));
        }
        uint4 pf[2][2]; bool act[2];
#pragma unroll
        for (int g = 0; g < 2; ++g) {
            act[g] = !band || (g == 0 ? kr <= rsA + 7 : kr >= rsB);
            if (!act[g]) continue;
            f32x4 sa[4]; float pm = -1e30f;
#pragma unroll
            for (int kt = 0; kt < 4; ++kt) {
                sa[kt] = (f32x4){0.f, 0.f, 0.f, 0.f};
                if (on[kt]) {
                    sa[kt] = __builtin_amdgcn_mfma_f32_16x16x32_bf16(k0[kt], q0[g], sa[kt], 0, 0, 0);
                    sa[kt] = __builtin_amdgcn_mfma_f32_16x16x32_bf16(k1[kt], q1[g], sa[kt], 0, 0, 0);
                }
            }
            if (band) {
                const float* rs = (const float*)((const unsigned char*)lds + 65536) + (kr - (rrA + g) + 7) * 31 + (15 - cq);
#pragma unroll
                for (int kt = 0; kt < 4; ++kt) if (on[kt]) {
#pragma unroll
                    for (int e = 0; e < 4; ++e) {
                        const int kk = 16 * kt + 4 * fq + e; const bool valid = (unsigned)(kk - cst) < 16u;
                        const float bias = rs[valid ? kk : cq];
                        const float sv = valid ? sa[kt][e] * 0.18033688f + bias : -1e30f;
                        sa[kt][e] = sv; pm = fmaxf(pm, sv);
                    }
                }
            } else {
#pragma unroll
                for (int kt = 0; kt < 4; ++kt)
#pragma unroll
                    for (int e = 0; e < 4; ++e) { const float sv = sa[kt][e] * 0.18033688f; sa[kt][e] = sv; pm = fmaxf(pm, sv); }
            }
            pm = xmax32(xmax16(pm));
            const float mn = fmaxf(m[g], pm); const float alpha = __builtin_amdgcn_exp2f(m[g] - mn); m[g] = mn;
            float ps = 0.f;
#pragma unroll
            for (int kt = 0; kt < 4; ++kt) {
                if (on[kt]) {
#pragma unroll
                    for (int e = 0; e < 4; ++e) { const float pv = __builtin_amdgcn_exp2f(sa[kt][e] - mn); sa[kt][e] = pv; ps += pv; }
                }
            }
            lsum[g] = lsum[g] * alpha + ps;
#pragma unroll
            for (int dt = 0; dt < 4; ++dt) o[g][dt] *= alpha;
#pragma unroll
            for (int s2 = 0; s2 < 2; ++s2)
                pf[g][s2] = make_uint4(pk2(sa[2 * s2][0], sa[2 * s2][1]), pk2(sa[2 * s2][2], sa[2 * s2][3]), pk2(sa[2 * s2 + 1][0], sa[2 * s2 + 1][1]), pk2(sa[2 * s2 + 1][2], sa[2 * s2 + 1][3]));
        }
#pragma unroll
        for (int s2 = 0; s2 < 2; ++s2) {
            if (!(on[2 * s2] || on[2 * s2 + 1])) continue;
            const int sw = (fr >> 1) & 7;
            const int a0 = (((4 * s2 + (fq >> 1)) ^ sw) << 4) + (fq & 1) * 8, a1 = (((4 * s2 + 2 + (fq >> 1)) ^ sw) << 4) + (fq & 1) * 8;
#pragma unroll
            for (int dt = 0; dt < 4; ++dt) {
                union { uint4 u; bf16x8 v; } vf;
                const u32x2 lo = *(const LAS u32x2*)(Vb + (16 * dt + fr) * 128 + a0), hi = *(const LAS u32x2*)(Vb + (16 * dt + fr) * 128 + a1);
                vf.u.x = lo[0]; vf.u.y = lo[1]; vf.u.z = hi[0]; vf.u.w = hi[1];
#pragma unroll
                for (int g = 0; g < 2; ++g) if (act[g]) { union { uint4 u; bf16x8 v; } pq; pq.u = pf[g][s2]; o[g][dt] = __builtin_amdgcn_mfma_f32_16x16x32_bf16(vf.v, pq.v, o[g][dt], 0, 0, 0); }
            }
        }
    }
#undef ATT_PTRS
#pragma unroll
    for (int g = 0; g < 2; ++g) {
        const float lt = xsum32(xsum16(lsum[g]));
        const float inv = 1.f / lt;
#pragma unroll
        for (int dt = 0; dt < 4; ++dt) o[g][dt] *= inv;
        const uint2 s0 = pk4(o[g][0]), s1 = pk4(o[g][1]), s2 = pk4(o[g][2]), s3 = pk4(o[g][3]);
        bf16_t* yo = Y + (size_t)(b * 4096 + (rrA + g) * 64 + cq) * YW + 256 + h * 64 + 16 * fq;
        *(uint4*)yo = make_uint4(s0.x, s0.y, s1.x, s1.y); *(uint4*)(yo + 8) = make_uint4(s2.x, s2.y, s3.x, s3.y);
    }
}

__device__ __forceinline__ void conv_tile(const Params& p, int l, int tile, unsigned char* ldsg) {
    const int tid = opq_tid(), lane = tid & 63, wave = tid >> 6;
    bf16_t* hb = (bf16_t*)ldsg;
    float* ob = (float*)(ldsg + 32768);
    const bf16_t* PL = (const bf16_t*)(p.ws + OFF_PL); bf16_t* Y = (bf16_t*)(p.ws + OFF_Y);
    const int row0 = tile * 32; const bool lat = row0 < NLAT;
    const int t0 = lat ? (row0 & 4095) : ((row0 - NLAT) & 255); const int T = lat ? 4096 : 256; const int seqbase = row0 - t0;
    uint4 av[8], gv[8];
#pragma unroll
    for (int q = 0; q < 8; ++q) {
        const int idx = tid + NTHREADS * q; const int r = idx >> 5, cch = idx & 31; const int tt = min(max(t0 - 15 + r, 0), T - 1);
        const bf16_t* src = PL + (size_t)(seqbase + tt) * PLW + cch * 8;
        av[q] = *(const uint4*)src; gv[q] = *(const uint4*)(src + 256);
    }
    float w[31];
    const float* cw = p.in[8] + (size_t)l * 31 * 256 + tid;
#pragma unroll
    for (int k = 0; k < 31; ++k) w[k] = cw[k * 256];
    const float cb = p.in[9][l * 256 + tid];
    __syncthreads();
#pragma unroll
    for (int q = 0; q < 8; ++q) {
        const int idx = tid + NTHREADS * q; const int r = idx >> 5, cch = idx & 31; const int tt = t0 - 15 + r;
        if (idx < 62 * 32) {
            const u32 a4[4] = {av[q].x, av[q].y, av[q].z, av[q].w}, g4[4] = {gv[q].x, gv[q].y, gv[q].z, gv[q].w}; u32 ov[4];
#pragma unroll
            for (int e = 0; e < 4; ++e) {
                const float h0 = __uint_as_float(a4[e] << 16) * sigmoid_f(__uint_as_float(g4[e] << 16));
                const float h1 = __uint_as_float(a4[e] & 0xffff0000u) * sigmoid_f(__uint_as_float(g4[e] & 0xffff0000u));
                ov[e] = pk2(h0, h1);
            }
            const bool ok = tt >= 0 && tt < T;
            *(uint4*)(hb + r * 256 + cch * 8) = ok ? make_uint4(ov[0], ov[1], ov[2], ov[3]) : make_uint4(0u, 0u, 0u, 0u);
        }
    }
    __syncthreads();
    {
        float hv[62];
#pragma unroll
        for (int i = 0; i < 62; ++i) hv[i] = bf2f(hb[i * 256 + tid]);
#pragma unroll
        for (int t = 0; t < 32; ++t) {
            float acc = cb;
#pragma unroll
            for (int k = 0; k < 31; ++k) acc += hv[t + k] * w[k];
            ob[t * 256 + tid] = acc;
        }
    }
    __syncthreads();
    const f32x4 lg = *(const f32x4*)(p.in[10] + l * 256 + lane * 4), lb = *(const f32x4*)(p.in[11] + l * 256 + lane * 4);
    f32x4 v[8]; float sm[8];
#pragma unroll
    for (int i = 0; i < 8; ++i) { v[i] = *(const f32x4*)(ob + (wave * 8 + i) * 256 + lane * 4); sm[i] = (v[i][0] + v[i][1]) + (v[i][2] + v[i][3]); }
#pragma unroll
    for (int i = 0; i < 8; ++i) sm[i] = wave_sum(sm[i]);
#pragma unroll
    for (int i = 0; i < 8; ++i) { v[i] = v[i] - sm[i] * (1.f / 256.f); sm[i] = (v[i][0] * v[i][0] + v[i][1] * v[i][1]) + (v[i][2] * v[i][2] + v[i][3] * v[i][3]); }
#pragma unroll
    for (int i = 0; i < 8; ++i) sm[i] = wave_sum(sm[i]);
#pragma unroll
    for (int i = 0; i < 8; ++i) {
        f32x4 y = v[i] * rsqrtf(sm[i] * (1.f / 256.f) + LN_EPS) * lg + lb;
#pragma unroll
        for (int e = 0; e < 4; ++e) y[e] = y[e] * sigmoid_f(y[e]);
        *(uint2*)(Y + (size_t)(row0 + wave * 8 + i) * YW + lane * 4) = pk4(y);
    }
}

__device__ __forceinline__ void dft_tile(const Params& p, int idx, LAS unsigned char* lds) {
    bf16_t* Y = (bf16_t*)(p.ws + OFF_Y);
    const int tidx = opq_tid(); const int lane = tidx & 63, wave = tidx >> 6, wr = wave >> 1, wc = wave & 1, fr = lane & 15, fq = lane >> 4;
    f32x4 acc[4][4];
    const int t = idx - 256; const int n = t & 1, m = (t >> 1) & 1, b = t >> 2;
    gemm_tile<true>(acc, (const bf16_t*)(p.ws + OFF_TWC) + (size_t)m * 128 * 512, 512, (const bf16_t*)(p.ws + OFF_HTC) + ((size_t)b * 256 + n * 128) * 512, 512, 512, lds);
    const int row0 = NLAT + b * 256 + m * 128;
#pragma unroll
    for (int mi = 0; mi < 4; ++mi) {
        const int row = row0 + wr * 64 + mi * 16 + fr;
#pragma unroll
        for (int ni = 0; ni < 4; ++ni) *(uint2*)(Y + (size_t)row * YW + 512 + n * 128 + wc * 64 + ni * 16 + 4 * fq) = pk4(acc[mi][ni]);
    }
}


__device__ __forceinline__ void fft_item(const Params& p, int item, unsigned char* ldsg, bf16_t* Yout, int ldy, int ycol0) {
    LAS unsigned char* lds = (LAS unsigned char*)ldsg;
    const float* tabh = (const float*)(ldsg + PREP_TAB_OFF);
    const int tid = opq_tid(), lane = tid & 63, fr = lane & 15, fq = lane >> 4;
    const int wave = __builtin_amdgcn_readfirstlane(tid >> 6);
    const int grp = (item & 7) * 8 + (item >> 6), dg = (item >> 3) & 7; const int b = grp >> 4, cg = grp & 15;
    bf16x8 f1[4];
    {
        const bf16_t* B1 = (const bf16_t*)(p.ws + OFF_FB1) + (size_t)(16 * dg + fr) * 128 + 8 * fq;
#pragma unroll
        for (int ks = 0; ks < 4; ++ks) f1[ks] = *(const bf16x8*)(B1 + 32 * ks);
    }
    __syncthreads();
#pragma unroll 1
    for (int jj = 0; jj < 4; ++jj) {
        const int j = 4 * wave + jj;
        const bf16_t* H = (const bf16_t*)(p.ws + OFF_HT2) + (((size_t)b * 256 + 16 * cg + j) * 64 + fr) * 128 + 8 * fq;
        bf16x8 h[4][4];
#pragma unroll
        for (int mt = 0; mt < 4; ++mt)
#pragma unroll
            for (int ks = 0; ks < 4; ++ks) h[mt][ks] = *(const bf16x8*)(H + (size_t)mt * 16 * 128 + 32 * ks);
        f32x4 acc[4];
#pragma unroll
        for (int mt = 0; mt < 4; ++mt) {
            acc[mt] = (f32x4){0.f, 0.f, 0.f, 0.f};
#pragma unroll
            for (int ks = 0; ks < 4; ++ks) acc[mt] = __builtin_amdgcn_mfma_f32_16x16x32_bf16(f1[ks], h[mt][ks], acc[mt], 0, 0, 0);
        }
#pragma unroll
        for (int mt = 0; mt < 4; ++mt) {
            const int a = 16 * mt + fr;
#pragma unroll
            for (int h2 = 0; h2 < 2; ++h2) {
                const int dl = 2 * fq + h2, d = 8 * dg + dl;
                const float re = acc[mt][2 * h2], im = acc[mt][2 * h2 + 1];
                const int m = a * d;
                const float cs = tab_cos(tabh, m), sn = tab_cos(tabh, m + 3072);
                const float re2 = re * cs + im * sn, im2 = im * cs - re * sn;
                const int row = 16 * dl + j;
                const int o0 = row * 256 + ((((a >> 3)) ^ (row & 15)) << 4) + (a & 7) * 2, o1 = row * 256 + (((8 + (a >> 3)) ^ (row & 15)) << 4) + (a & 7) * 2;
                *(LAS bf16_t*)(lds + o0) = f2bf(re2);
                *(LAS bf16_t*)(lds + o1) = f2bf(im2);
            }
        }
    }
    bf16x8 f3[4][4];
    {
        const bf16_t* B3 = (const bf16_t*)(p.ws + OFF_FB3) + (size_t)fr * 128 + 8 * fq;
#pragma unroll
        for (int ct = 0; ct < 4; ++ct)
#pragma unroll
            for (int ks = 0; ks < 4; ++ks) f3[ct][ks] = *(const bf16x8*)(B3 + (size_t)ct * 16 * 128 + 32 * ks);
    }
    __syncthreads();
#pragma unroll
    for (int dd = 0; dd < 2; ++dd) {
        const int dl = 2 * wave + dd; const int row = 16 * dl + fr;
        bf16x8 g[4];
#pragma unroll
        for (int ks = 0; ks < 4; ++ks) g[ks] = *(const LAS bf16x8*)(lds + row * 256 + (((4 * ks + fq) ^ (row & 15)) << 4));
#pragma unroll
        for (int ct = 0; ct < 4; ++ct) {
            f32x4 o = (f32x4){0.f, 0.f, 0.f, 0.f};
#pragma unroll
            for (int ks = 0; ks < 4; ++ks) o = __builtin_amdgcn_mfma_f32_16x16x32_bf16(g[ks], f3[ct][ks], o, 0, 0, 0);
            const int k = 64 * (16 * ct + fr) + 8 * dg + dl;
            *(uint2*)(Yout + (size_t)(b * 4096 + k) * ldy + ycol0 + 16 * cg + 4 * fq) = pk4(o);
        }
    }
}

__device__ __forceinline__ void ph_mixers_fast(const Params& p, int l, unsigned char* ldsg) {
    LAS unsigned char* lds = (LAS unsigned char*)ldsg;
    const bool ctx = (l == 0);
    const int nG = 2048, nN = 1024, nC = 512, nGc = ctx ? 128 : 0, nNc = ctx ? 64 : 0, nCc = ctx ? 32 : 0, nDc = ctx ? 16 : 0;
    const int vbx = blockIdx.x, G = gridDim.x;
    (void)nG; (void)nN;
    const int rot = vbx >= (G >> 1) ? 2 : 0;
#pragma unroll 1
    for (int st = 0; st < 4; ++st) {
        const int k = (st + rot) & 3;
        if (k == 0) {
            prep_tables(ldsg);
            for (int it = vbx; it < 512; it += G) fft_item(p, it, ldsg, (bf16_t*)(p.ws + OFF_Y), YW, 512);
        } else if (k == 1) { for (int it = vbx; it < 512; it += G) attn_gqa4(p, l, it, lds); }
        else if (k == 2) { for (int it = vbx; it < 512; it += G) attn_nat2(p, l, it, lds); }
        else { for (int it = vbx; it < nC; it += G) conv_tile(p, l, it, ldsg); }
    }
    if (ctx) {
        for (int it = vbx; it < nGc + nNc + nCc + nDc; it += G) {
            if (it < nGc) attn_item<0>(p, l, it, true, lds);
            else if (it < nGc + nNc) attn_item<0>(p, l, it - nGc, false, lds);
            else if (it < nGc + nNc + nCc) conv_tile(p, l, 512 + it - nGc - nNc, ldsg);
            else dft_tile(p, 256 + it - nGc - nNc - nCc, lds);
        }
    }
}


template <int BITS>
__device__ __forceinline__ void exp_load(const unsigned char* rowp, unsigned off2, u32 (&w)[EXPERT_BITS]) {
    const uint4 a = *(const uint4*)rowp;
    w[0] = a.x; w[1] = a.y; w[2] = a.z; w[3] = a.w;
    if (BITS == 6) { const uint2 c = *(const uint2*)(rowp + off2); w[4] = c.x; w[5] = c.y; } else { w[4] = 0u; w[5] = 0u; }
}
template <int BITS>
__device__ __forceinline__ void exp_decode(const u32 (&w)[EXPERT_BITS], f32x2 (&o)[16]) {
    if (BITS == 6) {
        u32x6v v; v[0] = w[0]; v[1] = w[1]; v[2] = w[2]; v[3] = w[3]; v[4] = w[4]; v[5] = w[5];
        const f32x32v r = __builtin_amdgcn_cvt_scalef32_pk32_f32_fp6(v, 1.0f);
#pragma unroll
        for (int k = 0; k < 16; ++k) o[k] = (f32x2){r[2 * k], r[2 * k + 1]};
    } else {
#pragma unroll
        for (int q = 0; q < 4; ++q) {
            o[4 * q + 0] = __builtin_amdgcn_cvt_scalef32_pk_f32_fp4(w[q], 1.0f, 0); o[4 * q + 1] = __builtin_amdgcn_cvt_scalef32_pk_f32_fp4(w[q], 1.0f, 1);
            o[4 * q + 2] = __builtin_amdgcn_cvt_scalef32_pk_f32_fp4(w[q], 1.0f, 2); o[4 * q + 3] = __builtin_amdgcn_cvt_scalef32_pk_f32_fp4(w[q], 1.0f, 3);
        }
    }
}
__device__ __forceinline__ void ph_expert_sub(const Params& p, int l, int nrows, float* outlat, float* outctx, bool fuse_next, int vb, int nblk) {
    const int tidx = opq_tid(); const int wave = tidx >> 6, lane = tidx & 63;
    const float* mods = (const float*)(p.ws + OFF_MODS) + (size_t)l * 5 * 6144;
    const bf16_t* Zb = (const bf16_t*)(p.ws + OFF_Z); const bf16_t* U = (const bf16_t*)(p.ws + OFF_U);
    const float* l1g = p.in[19] + l * 1024; const float* l1b = p.in[20] + l * 1024;
    const int* EIDX = (const int*)(p.ws + OFF_EIDX); const float* GATE = (const float*)(p.ws + OFF_GATE);
    const unsigned char* EU = p.ws + OFF_EUV + (size_t)(l * 2) * 16384 * EXP_ROWB; const unsigned char* EV = EU + (size_t)16384 * EXP_ROWB;
    bf16_t* XLN = (bf16_t*)(p.ws + OFF_XLN);
    const float* lg = p.in[26] + l * 1024; const float* lb = p.in[27] + l * 1024;
    const int hf = lane >> 5, j = lane & 31, b4 = (lane >> 4) & 1, b3 = (lane >> 3) & 1;
    const int eL = 4 * b4 + 2 * b3 + hf;
    const unsigned laneoff = (unsigned)j * 16u, off2 = 512u - (unsigned)j * 8u;
    for (int r = vb * 4 + wave; r < nrows; r += nblk * 4) {
        f32x2 u[16];
        {
            const bf16_t* up = U + (size_t)r * 1024 + j * 32;
#pragma unroll
            for (int q = 0; q < 4; ++q) {
                const uint4 t = *(const uint4*)(up + 8 * q); const u32 tw[4] = {t.x, t.y, t.z, t.w};
#pragma unroll
                for (int k = 0; k < 4; ++k) u[4 * q + k] = (f32x2){__uint_as_float(tw[k] << 16), __uint_as_float(tw[k] & 0xffff0000u)};
            }
        }
        const int ei0 = EIDX[(size_t)r * 128 + lane], ei1 = EIDX[(size_t)r * 128 + 64 + lane];
        const float gt0 = GATE[(size_t)r * 128 + lane], gt1 = GATE[(size_t)r * 128 + 64 + lane];
        f32x2 acc2[16];
#pragma unroll
        for (int i = 0; i < 16; ++i) acc2[i] = (f32x2){0.f, 0.f};
#pragma unroll 1
        for (int bt = 0; bt < 16; ++bt) {
            const int eib = bt < 8 ? ei0 : ei1; const float gtb = bt < 8 ? gt0 : gt1; const int kb = (bt & 7) * 8;
            unsigned re[4];
#pragma unroll
            for (int q = 0; q < 4; ++q) { const int ea = __builtin_amdgcn_readlane(eib, kb + 2 * q), eb = __builtin_amdgcn_readlane(eib, kb + 2 * q + 1); re[q] = (unsigned)(hf ? eb : ea); }
            u32 wu[4][EXPERT_BITS], wv[4][EXPERT_BITS];
#pragma unroll
            for (int q = 0; q < 4; ++q) exp_load<EU_BITS>(EU + (size_t)re[q] * (EU_BITS * 128) + laneoff, off2, wu[q]);
#pragma unroll
            for (int q = 0; q < 4; ++q) exp_load<EV_BITS>(EV + (size_t)re[q] * (EV_BITS * 128) + laneoff, off2, wv[q]);
            float d[4];
#pragma unroll
            for (int q = 0; q < 4; ++q) {
                f32x2 w[16]; exp_decode<EU_BITS>(wu[q], w);
                f32x2 dd = w[0] * u[0];
#pragma unroll
                for (int k = 1; k < 16; ++k) dd = __builtin_elementwise_fma(w[k], u[k], dd);
                d[q] = dd[0] + dd[1];
            }
            float r1[2], r3;
#pragma unroll
            for (int i = 0; i < 2; ++i) { float a = d[i], b = d[i + 2]; swap16(a, b); r1[i] = a + b; }
            { const float snd = b3 ? r1[0] : r1[1], keep = b3 ? r1[1] : r1[0]; r3 = keep + dpp_f<DPP_ROR8>(snd); }
            r3 = sum8(r3);
            const float g = __builtin_bit_cast(float, __builtin_amdgcn_ds_bpermute((kb + eL) << 2, __builtin_bit_cast(int, gtb)));
            const float coef = g * gelu_erf(r3 * (1.f / EU_SCALE)) * (1.f / EV_SCALE);
#pragma unroll
            for (int q = 0; q < 4; ++q) {
                const int src = ((q >> 1) & 1) * 16 + (q & 1) * 8;
                const float c0 = __builtin_bit_cast(float, __builtin_amdgcn_readlane(__builtin_bit_cast(int, coef), src));
                const float c1 = __builtin_bit_cast(float, __builtin_amdgcn_readlane(__builtin_bit_cast(int, coef), src + 32));
                const float c = hf ? c1 : c0;
                f32x2 w[16]; exp_decode<EV_BITS>(wv[q], w);
                const f32x2 cc = (f32x2){c, c};
#pragma unroll
                for (int k = 0; k < 16; ++k) acc2[k] = __builtin_elementwise_fma(w[k], cc, acc2[k]);
            }
        }
        float acc[16];
#pragma unroll
        for (int k = 0; k < 8; ++k) {
            { float a = acc2[k][0], b = acc2[8 + k][0]; swap32(a, b); acc[2 * k] = a + b; }
            { float a = acc2[k][1], b = acc2[8 + k][1]; swap32(a, b); acc[2 * k + 1] = a + b; }
        }
        const int ebase = 32 * j + 16 * hf;
        const int mi = row_mod(r);
        const float* g2 = mods + (size_t)mi * 6144 + 5120;
        f32x4 zv[4]; float sz = 0.f;
#pragma unroll
        for (int h = 0; h < 4; ++h) { const uint2 t = *(const uint2*)(Zb + (size_t)r * 1024 + ebase + 4 * h);
            zv[h] = (f32x4){__uint_as_float(t.x << 16), __uint_as_float(t.x & 0xffff0000u), __uint_as_float(t.y << 16), __uint_as_float(t.y & 0xffff0000u)}; sz += (zv[h][0] + zv[h][1]) + (zv[h][2] + zv[h][3]); }
        const float mz = wave_sum(sz) * (1.f / 1024.f); float qz = 0.f;
#pragma unroll
        for (int h = 0; h < 4; ++h) { zv[h] = zv[h] - mz; qz += (zv[h][0] * zv[h][0] + zv[h][1] * zv[h][1]) + (zv[h][2] * zv[h][2] + zv[h][3] * zv[h][3]); }
        const float rz = rsqrtf(wave_sum(qz) * (1.f / 1024.f) + LN_EPS);
        float s = 0.f;
#pragma unroll
        for (int h = 0; h < 4; ++h) {
            const int i0 = ebase + 4 * h;
            const f32x4 x = zv[h] * rz * *(const f32x4*)(l1g + i0) + *(const f32x4*)(l1b + i0), gg = *(const f32x4*)(g2 + i0);
#pragma unroll
            for (int q = 0; q < 4; ++q) { const float v = ALPHA * x[q] + gg[q] * acc[4 * h + q]; acc[4 * h + q] = v; s += v; }
        }
        const float mean = wave_sum(s) * (1.f / 1024.f); float q2 = 0.f;
#pragma unroll
        for (int i = 0; i < 16; ++i) { acc[i] -= mean; q2 += acc[i] * acc[i]; }
        const float rstd = rsqrtf(wave_sum(q2) * (1.f / 1024.f) + LN_EPS);
        float* dst = r < NLAT ? outlat + (size_t)r * 1024 : outctx + (size_t)(r - NLAT) * 1024;
        float s2 = 0.f;
#pragma unroll
        for (int h = 0; h < 4; ++h) {
            const int i0 = ebase + 4 * h;
            const f32x4 a = *(const f32x4*)(lg + i0), bb = *(const f32x4*)(lb + i0);
            f32x4 o;
#pragma unroll
            for (int q = 0; q < 4; ++q) { o[q] = acc[4 * h + q] * rstd * a[q] + bb[q]; acc[4 * h + q] = o[q]; s2 += o[q]; }
            *(f32x4*)(dst + i0) = o;
        }
        if (fuse_next) {
            const float* sh = mods + (size_t)5 * 6144 + (size_t)mi * 6144; const float* sc = sh + 1024;
            const float mean2 = wave_sum(s2) * (1.f / 1024.f); float q3 = 0.f;
#pragma unroll
            for (int i = 0; i < 16; ++i) { acc[i] -= mean2; q3 += acc[i] * acc[i]; }
            const float rstd2 = rsqrtf(wave_sum(q3) * (1.f / 1024.f) + LN_EPS);
#pragma unroll
            for (int jj = 0; jj < 2; ++jj) {
                const int i0 = ebase + 8 * jj;
                const f32x4 a0 = *(const f32x4*)(sc + i0), a1 = *(const f32x4*)(sc + i0 + 4), c0 = *(const f32x4*)(sh + i0), c1 = *(const f32x4*)(sh + i0 + 4);
                uint4 o;
                o.x = pk2(acc[8 * jj + 0] * rstd2 * (1.f + a0[0]) + c0[0], acc[8 * jj + 1] * rstd2 * (1.f + a0[1]) + c0[1]);
                o.y = pk2(acc[8 * jj + 2] * rstd2 * (1.f + a0[2]) + c0[2], acc[8 * jj + 3] * rstd2 * (1.f + a0[3]) + c0[3]);
                o.z = pk2(acc[8 * jj + 4] * rstd2 * (1.f + a1[0]) + c1[0], acc[8 * jj + 5] * rstd2 * (1.f + a1[1]) + c1[1]);
                o.w = pk2(acc[8 * jj + 6] * rstd2 * (1.f + a1[2]) + c1[2], acc[8 * jj + 7] * rstd2 * (1.f + a1[3]) + c1[3]);
                *(uint4*)(XLN + (size_t)r * 1024 + i0) = o;
            }
        }
    }
}

__device__ __forceinline__ u32 f2sort(float f) { const u32 u = __float_as_uint(f); return u ^ ((u32)((int)u >> 31) | 0x80000000u); }
__device__ __forceinline__ float sort2f(u32 k) { return __uint_as_float((k & 0x80000000u) ? (k ^ 0x80000000u) : ~k); }
__device__ __forceinline__ void ins16(u32 (&L)[16], u32 x) {
#pragma unroll
    for (int j = 0; j < 16; ++j) { const u32 hi = L[j] > x ? L[j] : x; x = L[j] > x ? x : L[j]; L[j] = hi; }
}
__device__ __forceinline__ void ce_desc(u32& a, u32& b) { const u32 hi = a > b ? a : b, lo = a > b ? b : a; a = hi; b = lo; }
__device__ __forceinline__ void sort16(u32 (&C)[16]) {
#pragma unroll
    for (int k = 2; k <= 16; k <<= 1)
#pragma unroll
        for (int j = k >> 1; j > 0; j >>= 1)
#pragma unroll
            for (int i = 0; i < 16; ++i) { const int o = i ^ j; if (o > i) { if ((i & k) == 0) ce_desc(C[i], C[o]); else ce_desc(C[o], C[i]); } }
}
__device__ __forceinline__ void merge16(u32 (&L)[16], const u32 (&C)[16]) {
#pragma unroll
    for (int i = 0; i < 16; ++i) L[i] = L[i] > C[15 - i] ? L[i] : C[15 - i];
#pragma unroll
    for (int j = 8; j > 0; j >>= 1)
#pragma unroll
        for (int i = 0; i < 16; ++i) if ((i & j) == 0) ce_desc(L[i], L[i + j]);
}
__device__ __forceinline__ void ph_topk_fast(const Params& p, int l, int nrows, unsigned char* ldsg, int vb) {
    LAS unsigned char* lds = (LAS unsigned char*)ldsg;
    const int tid = opq_tid(), lane = tid & 63, fr = lane & 15, fq = lane >> 4;
    const int wave = __builtin_amdgcn_readfirstlane(tid >> 6); const int wr = wave >> 1, wc = wave & 1;
    const bf16_t* U = (const bf16_t*)(p.ws + OFF_U);
    const bf16_t* WT = (const bf16_t*)(p.ws + OFF_WQT) + (size_t)l * 2048 * 1024;
    const bf16_t* K12 = (const bf16_t*)(p.ws + OFF_K12);
    int* EIDX = (int*)(p.ws + OFF_EIDX); float* GATE = (float*)(p.ws + OFF_GATE);
    LAS u32* X = (LAS u32*)lds;
    LAS u32* T1 = (LAS u32*)(lds + 16384);
    LAS u32* T0 = (LAS u32*)(lds + 65536);
    const int srow = lane >> 3, sch = (lane & 7) ^ (lane >> 3);
    for (int it = 0;; ++it) {
        int m, h; if (!tile_sched(it, vb, nrows / 128, 8, m, h)) break;
        const int m0 = m * 128;
#pragma unroll 1
        for (int half = 0; half < 2; ++half) {
            f32x4 acc[4][4];
            gemm_tile<true>(acc, U + (size_t)m0 * 1024, 1024, WT + (size_t)(h * 256 + half * 128) * 1024, 1024, 1024, lds);
            __syncthreads();
#pragma unroll
            for (int mi = 0; mi < 4; ++mi) {
                const int row = 64 * wr + 16 * mi + fr;
#pragma unroll
                for (int ni = 0; ni < 4; ++ni) {
                    const uint2 v = pk4(acc[mi][ni]);
                    *(LAS u32x2*)(lds + wc * 32768 + row * 128 + (((2 * ni + (fq >> 1)) ^ (row & 7)) << 4) + (fq & 1) * 8) = (u32x2){v.x, v.y};
                }
            }
            const bf16_t* Kh = K12 + ((size_t)(half * 2 + l) * 8 + h) * 16384;
#pragma unroll
            for (int ks = 0; ks < 2; ++ks)
#pragma unroll
                for (int i = 0; i < 4; ++i) {
                    const int r = 32 * wave + 8 * i + srow;
                    __builtin_amdgcn_global_load_lds((const unsigned*)(Kh + (size_t)r * 128 + ks * 64 + sch * 8), (LAS unsigned*)(lds + ks * 32768 + 16384 + wave * 4096 + i * 1024), 16, 0, 0);
                }
            asm volatile("s_waitcnt vmcnt(0)" ::: "memory");
            __syncthreads();
            f32x4 sc[4][4];
#pragma unroll
            for (int mi = 0; mi < 4; ++mi)
#pragma unroll
                for (int ni = 0; ni < 4; ++ni) sc[mi][ni] = (f32x4){0.f, 0.f, 0.f, 0.f};
#pragma unroll
            for (int kk = 0; kk < 4; ++kk) {
                const LAS unsigned char* base = lds + (kk >> 1) * 32768;
                const int xo = (((kk & 1) * 4 + fq) ^ (fr & 7)) << 4;
                bf16x8 a[4], b[4];
#pragma unroll
                for (int mi = 0; mi < 4; ++mi) a[mi] = *(const LAS bf16x8*)(base + (wr * 64 + fr) * 128 + mi * 2048 + xo);
#pragma unroll
                for (int ni = 0; ni < 4; ++ni) b[ni] = *(const LAS bf16x8*)(base + 16384 + (wc * 64 + fr) * 128 + ni * 2048 + xo);
#pragma unroll
                for (int mi = 0; mi < 4; ++mi)
#pragma unroll
                    for (int ni = 0; ni < 4; ++ni) sc[mi][ni] = __builtin_amdgcn_mfma_f32_16x16x32_bf16(b[ni], a[mi], sc[mi][ni], 0, 0, 0);
            }
            __syncthreads();
#pragma unroll
            for (int mi = 0; mi < 4; ++mi) {
                const int row = 64 * wr + 16 * mi + fr;
#pragma unroll
                for (int ni = 0; ni < 4; ++ni) *(LAS f32x4*)(lds + row * 512 + (((16 * wc + 4 * ni + fq) ^ (row & 15)) << 4)) = sc[mi][ni];
            }
            __syncthreads();
            const int r = tid & 127, hs = tid >> 7;
            u32 L[16];
#pragma unroll
            for (int j = 0; j < 16; ++j) L[j] = 0u;
#pragma unroll 1
            for (int q4 = 0; q4 < 4; ++q4) {
                u32 C[16];
#pragma unroll
                for (int q = 0; q < 4; ++q) {
                    const int c4 = hs * 16 + q4 * 4 + q;
                    const f32x4 v = *(const LAS f32x4*)(lds + r * 512 + ((c4 ^ (r & 15)) << 4));
#pragma unroll
                    for (int e = 0; e < 4; ++e) C[4 * q + e] = (f2sort(v[e]) & ~127u) | (u32)(127 - (c4 * 4 + e));
                }
                sort16(C); merge16(L, C);
            }
            __syncthreads();
            if (hs == 1) {
#pragma unroll
                for (int j = 0; j < 16; ++j) X[r * 17 + j] = L[j];
            }
            __syncthreads();
            if (hs == 0) {
                u32 C[16];
#pragma unroll
                for (int j = 0; j < 16; ++j) C[j] = X[r * 17 + j];
                merge16(L, C);
                LAS u32* T = half == 0 ? T0 : T1;
#pragma unroll
                for (int j = 0; j < 16; ++j) T[r * 17 + j] = L[j];
            }
        }
        __syncthreads();
        if (tid < 128) {
            const int r = tid;
            float va[16], vbv[16];
#pragma unroll
            for (int a = 0; a < 16; ++a) { va[a] = sort2f(T0[r * 17 + a] & ~127u); vbv[a] = sort2f(T1[r * 17 + a] & ~127u); }
#define CKEY(a, b) ((f2sort(va[a] + vbv[b]) & ~255u) | (u32)(255 - ((a) * 16 + (b))))
            u32 L[16];
#pragma unroll
            for (int j = 0; j < 16; ++j) L[j] = CKEY(0, j);
            {
                u32 C[16];
#pragma unroll
                for (int b = 0; b < 8; ++b) C[b] = CKEY(1, b);
#pragma unroll
                for (int b = 0; b < 5; ++b) C[8 + b] = CKEY(2, b);
#pragma unroll
                for (int b = 0; b < 3; ++b) C[13 + b] = CKEY(4, b);
                sort16(C); merge16(L, C);
#pragma unroll
                for (int b = 0; b < 4; ++b) C[b] = CKEY(3, b);
#pragma unroll
                for (int a = 5; a < 8; ++a) { C[4 + 2 * (a - 5)] = CKEY(a, 0); C[5 + 2 * (a - 5)] = CKEY(a, 1); }
#pragma unroll
                for (int a = 8; a < 14; ++a) C[10 + (a - 8)] = CKEY(a, 0);
                sort16(C); merge16(L, C);
            }
            ins16(L, CKEY(14, 0)); ins16(L, CKEY(15, 0));
#undef CKEY
            const float mx = sort2f(L[0] & ~255u);
            float ge[16]; int eo[16]; float sum = 0.f;
#pragma unroll
            for (int j = 0; j < 16; ++j) {
                const u32 key = L[j]; const int pos = 255 - (int)(key & 255u);
                const int i1 = 127 - (int)(T0[r * 17 + (pos >> 4)] & 127u), i2 = 127 - (int)(T1[r * 17 + (pos & 15)] & 127u);
                eo[j] = i1 * 128 + i2;
                ge[j] = __expf(sort2f(key & ~255u) - mx); sum += ge[j];
            }
            const float inv = 1.f / sum;
            int* ed = EIDX + (size_t)(m0 + r) * 128 + h * 16; float* gd = GATE + (size_t)(m0 + r) * 128 + h * 16;
#pragma unroll
            for (int j = 0; j < 16; j += 4) {
                *(int4*)(ed + j) = make_int4(eo[j], eo[j + 1], eo[j + 2], eo[j + 3]);
                *(float4*)(gd + j) = make_float4(ge[j] * inv, ge[j + 1] * inv, ge[j + 2] * inv, ge[j + 3] * inv);
            }
        }
    }
}


#define NPHASES 21
#define PHASE_SKIP_MASK ((1u << 3) | (1u << 8) | (1u << 11) | (1u << 13) | (1u << 18))
__device__ __forceinline__ void run_phase(const Params& p, int ph, unsigned char* lds, volatile LAS unsigned* misc, int vb, int nblk) {
    LAS unsigned char* ldsl = (LAS unsigned char*)lds;
    if (ph == 0) {
        ph_prep_fast(p, lds, vb, nblk);
        return; }
    const int l = (ph - 1) / 10, s = (ph - 1) % 10;
    float* XC2 = (float*)(p.ws + OFF_XC2);
    const float* xlat = l == 0 ? p.in[0] : p.out; const float* xctx = l == 0 ? p.in[2] : XC2;
    const int nrows = l == 0 ? NROWS : NLAT;
    switch (s) {
    case 0: if (l == 0) ph_lnmod(p, l, xlat, xctx, vb, nblk); break;
    case 1: ph_inproj_fast(p, l, lds, vb, nblk); break;
    case 2: break;
    case 3: ph_mixers_fast(p, l, lds); break;
    case 4:
            ph_merge_fast(p, l, nrows, ldsl, vb); if (l == 0 && (vb >> 3) >= 8) euv_queue_work(p, misc, 8); break;
    case 5: ph_wout_fast(p, l, nrows, xlat, xctx, ldsl, vb); if (l == 0 && (vb >> 3) >= 8) euv_queue_work(p, misc, 8); break;
    case 6: ph_ln1(p, l, nrows, vb, nblk); break;
    case 7: break;
    case 8: ph_topk_fast(p, l, nrows, lds, vb); if (l == 0) euv_queue_work(p, misc, 8192); break;
    case 9: ph_expert_sub(p, l, nrows, p.out, XC2, l == 0, vb, nblk); break;
    }
}

#define LDS_BYTES (80 * 1024)
#define LDS_MISC_OFF (LDS_BYTES - 64)
__global__ void __launch_bounds__(NTHREADS, 2) mega(Params p) {
    extern __shared__ __attribute__((aligned(16))) unsigned char lds[];
    volatile LAS unsigned* misc = (volatile LAS unsigned*)((LAS unsigned char*)lds + LDS_MISC_OFF);
    if (threadIdx.x < 16) misc[threadIdx.x] = 0u;
    __syncthreads();
    XcdBarrier bar; bar.bar = (unsigned*)(p.ws + OFF_CTL); bar.x = 0; bar.st = misc;
    const bool multi = (p.ph_hi - p.ph_lo) > 1;
    if (multi) bar = xcd_barrier_post((unsigned*)(p.ws + OFF_CTL), misc);
    const int vb = blockIdx.x, nblk = gridDim.x;
    for (int ph = p.ph_lo; ph < p.ph_hi; ++ph) {
        if ((PHASE_SKIP_MASK >> ph) & 1) continue;
        run_phase(p, ph, lds, misc, vb, nblk);
        if (ph + 1 < p.ph_hi) xcd_barrier(bar);
    }
}

#ifndef N_LAUNCH_MODE
#define N_LAUNCH_MODE 1
#endif

extern "C" void kernel_launch(void* const* d_in, const int* in_sizes, int n_in, void* d_out, int out_size, void* d_ws, size_t ws_size, hipStream_t stream) {
    static int grid = 0;
    if (grid == 0) {
        if (n_in != 28 || ws_size < WS_END) { fprintf(stderr, "kernel_launch: unexpected n_in %d or ws_size %zu < %zu\n", n_in, ws_size, (size_t)WS_END); grid = -1; return; }
        int dev = 0, cus = 0, per_cu = 0;
        hipGetDevice(&dev); hipDeviceGetAttribute(&cus, hipDeviceAttributeMultiprocessorCount, dev);
        hipFuncSetAttribute((const void*)mega, hipFuncAttributeMaxDynamicSharedMemorySize, LDS_BYTES);
        hipOccupancyMaxActiveBlocksPerMultiprocessor(&per_cu, (const void*)mega, NTHREADS, LDS_BYTES);
        (void)hipGetLastError();
        if (per_cu < 1) per_cu = 1;
        if (per_cu > 2) per_cu = 2;
        grid = cus * per_cu;
    }
    if (grid < 0) return;
    hipMemsetAsync((char*)d_ws + OFF_CTL, 0, 65536, stream);
    Params p{};
    for (int i = 0; i < 28; ++i) p.in[i] = (const float*)d_in[i];
    p.out = (float*)d_out; p.ws = (unsigned char*)d_ws;
    p.ph_lo = 0; p.ph_hi = NPHASES;
    hipLaunchKernelGGL(mega, dim3(grid), dim3(NTHREADS), LDS_BYTES, stream, p);
}
```

```cpp
#include <hip/hip_runtime.h>
#include <cstdio>
#include <cstdint>

typedef unsigned short bf16_t;
typedef unsigned int u32;

#define NBATCH 4
#define SEQ 4096
#define CTXL 256
#define NLAT (NBATCH * SEQ)
#define NCTX (NBATCH * CTXL)
#define NROWS (NLAT + NCTX)
#define INTOT 6400
#define PLW 1664
#define PL_CONV 0
#define PL_NQ 512
#define PL_NK 768
#define PL_GQ 1024
#define PL_GK 1536
#define YW 1280
#define LN_EPS 1e-5f
#define ALPHA 1.41421356237f
#define NTHREADS 256

constexpr size_t al256(size_t x) { return (x + 255) & ~(size_t)255; }
constexpr size_t OFF_CTL  = 0;
constexpr size_t OFF_MODS = 65536;
constexpr size_t OFF_XLN  = al256(OFF_MODS + 2 * 5 * 6144 * 4);
constexpr size_t OFF_M    = OFF_XLN;
constexpr size_t OFF_Y    = al256(OFF_XLN + (size_t)NROWS * 1024 * 2);
constexpr size_t OFF_XC2  = al256(OFF_Y + (size_t)NROWS * YW * 2);
constexpr size_t OFF_PL   = al256(OFF_XC2 + (size_t)NCTX * 1024 * 4);
constexpr size_t OFF_G8   = al256(OFF_PL + (size_t)NROWS * PLW * 2);
constexpr size_t OFF_NVT  = al256(OFF_G8 + (size_t)NROWS * 4096);
constexpr size_t OFF_NVTC = al256(OFF_NVT + (size_t)4 * 256 * 4096 * 2);
constexpr size_t OFF_GVT  = al256(OFF_NVTC + (size_t)4 * 256 * 256 * 2);
constexpr size_t OFF_GVTC = al256(OFF_GVT + (size_t)4 * 128 * 4096 * 2);
constexpr size_t OFF_HT   = al256(OFF_GVTC + (size_t)4 * 128 * 256 * 2);
constexpr size_t OFF_HTC  = al256(OFF_HT + (size_t)4 * 256 * 8192 * 2);
constexpr size_t OFF_PLEND0 = al256(OFF_HTC + (size_t)4 * 256 * 512 * 2);
constexpr size_t OFF_Z    = OFF_PL;
constexpr size_t OFF_U    = al256(OFF_Z + (size_t)NROWS * 1024 * 4);
constexpr size_t OFF_EIDX = al256(OFF_U + (size_t)NROWS * 1024 * 2);
constexpr size_t OFF_GATE = al256(OFF_EIDX + (size_t)NROWS * 128 * 4);
constexpr size_t OFF_PEND2 = al256(OFF_GATE + (size_t)NROWS * 128 * 4);
constexpr size_t OFF_PLEND = OFF_PLEND0 > OFF_PEND2 ? OFF_PLEND0 : OFF_PEND2;
constexpr size_t OFF_WINT = al256(OFF_PLEND);
constexpr size_t OFF_BINP = al256(OFF_WINT + (size_t)2 * 6656 * 1024 * 2);
constexpr size_t OFF_WBRT = al256(OFF_BINP + (size_t)2 * 6656 * 4);
constexpr size_t WBRT_L   = (size_t)1024 * 1280;
constexpr size_t OFF_WOT  = al256(OFF_WBRT + 2 * WBRT_L * 2);
constexpr size_t OFF_WQT  = al256(OFF_WOT + (size_t)2 * 1024 * 1024 * 2);
constexpr size_t OFF_K12  = al256(OFF_WQT + (size_t)2 * 2048 * 1024 * 2);
constexpr size_t OFF_EUV  = al256(OFF_K12 + (size_t)2 * 2 * 8 * 128 * 128 * 2);
constexpr size_t OFF_TWC  = al256(OFF_EUV + (size_t)2 * 2 * 16384 * 768);
constexpr size_t OFF_FB1  = al256(OFF_TWC + (size_t)256 * 512 * 2);
constexpr size_t OFF_FB3  = al256(OFF_FB1 + (size_t)128 * 128 * 2);
constexpr size_t OFF_HT2  = OFF_HT;
constexpr size_t WS_END   = al256(OFF_FB3 + (size_t)64 * 128 * 2);

struct Params {
    const float* in[28];
    float* out;
    unsigned char* ws;
    int ph_lo, ph_hi;
};

__device__ __forceinline__ float bf2f(bf16_t v) { return __uint_as_float(((u32)v) << 16); }
__device__ __forceinline__ bf16_t f2bf(float f) { return __builtin_bit_cast(bf16_t, (__bf16)f); }
__device__ __forceinline__ float sigmoid_f(float x) { return __builtin_amdgcn_rcpf(1.f + __builtin_amdgcn_exp2f(x * -1.4426950409f)); }
__device__ __forceinline__ float silu_f(float x) { return x / (1.f + __expf(-x)); }
template <int CTRL> __device__ __forceinline__ float dpp_f(float v) { return __builtin_bit_cast(float, __builtin_amdgcn_update_dpp(0, __builtin_bit_cast(int, v), CTRL, 0xf, 0xf, true)); }
__device__ __forceinline__ void swap16(float& a, float& b) { asm volatile("s_nop 1\n\tv_permlane16_swap_b32 %0, %1" : "+v"(a), "+v"(b)); }
__device__ __forceinline__ void swap32(float& a, float& b) { asm volatile("s_nop 1\n\tv_permlane32_swap_b32 %0, %1" : "+v"(a), "+v"(b)); }
#define DPP_XOR1 0xB1
#define DPP_XOR2 0x4E
#define DPP_HALF_MIRROR 0x141
#define DPP_MIRROR 0x140
#define DPP_ROR8 0x128
__device__ __forceinline__ float sum8(float v) { v += dpp_f<DPP_XOR1>(v); v += dpp_f<DPP_XOR2>(v); v += dpp_f<DPP_HALF_MIRROR>(v); return v; }
__device__ __forceinline__ float xsum16(float v) { float a = v, b = v; swap16(a, b); return a + b; }
__device__ __forceinline__ float xsum32(float v) { float a = v, b = v; swap32(a, b); return a + b; }
__device__ __forceinline__ float xmax16(float v) { float a = v, b = v; swap16(a, b); return fmaxf(a, b); }
__device__ __forceinline__ float xmax32(float v) { float a = v, b = v; swap32(a, b); return fmaxf(a, b); }
__device__ __forceinline__ float wave_sum(float v) { v = sum8(v); v += dpp_f<DPP_MIRROR>(v); return xsum32(xsum16(v)); }
__device__ __forceinline__ void sincos_red(float a, float& s, float& c) {
    const float k = rintf(a * 0.15915494309189535f);
    float x = fmaf(-k, 6.2831854820251465f, a);
    x = fmaf(-k, -1.7484555e-7f, x);
    s = __sinf(x); c = __cosf(x);
}
__device__ __forceinline__ float gelu_erf(float x) {
    const float z = fabsf(x) * 0.70710678118f;
    const float t = __builtin_amdgcn_rcpf(fmaf(0.3275911f, z, 1.f));
    const float poly = t * fmaf(t, fmaf(t, fmaf(t, fmaf(t, 1.061405429f, -1.453152027f), 1.421413741f), -0.284496736f), 0.254829592f);
    const float hE = 0.5f * x * poly * __builtin_amdgcn_exp2f(z * z * -1.4426950409f);
    return x >= 0.f ? x - hE : hE;
}

#define XB_TMO      128
#define XB_XCNT(j)  (256  + 64 * (j))
#define XB_XSUB(j)  (1280 + 64 * (j))
#define XB_XGEN(j)  (2304 + 64 * (j))
#define XB_TOP      3328
#define XB_TOPGEN   3392
#define XCD_BAR_WORDS 3456
#define XB_SPIN_CAP (1u << 22)
#define LAS __attribute__((address_space(3)))
__device__ __forceinline__ unsigned xb_ld(unsigned* p)              { return __hip_atomic_load(p, __ATOMIC_RELAXED, __HIP_MEMORY_SCOPE_AGENT); }
__device__ __forceinline__ unsigned xb_add(unsigned* p, unsigned v) { return __hip_atomic_fetch_add(p, v, __ATOMIC_RELAXED, __HIP_MEMORY_SCOPE_AGENT); }
__device__ __forceinline__ unsigned xb_xcc_id() { return (unsigned)__builtin_amdgcn_s_getreg((3 << 11) | 20) & 0xFu; }
#define XB_SPIN(cond, bar) do { unsigned _sp = 0; while (cond) { __builtin_amdgcn_s_sleep(1); \
    if ((++_sp & 255u) == 0u) { if (xb_ld(&(bar)[XB_TMO])) break; if (_sp > XB_SPIN_CAP) { atomicAdd(&(bar)[XB_TMO], 1u); break; } } } } while (0)
struct XcdBarrier { unsigned* bar; unsigned x; volatile LAS unsigned* st; };
__device__ __forceinline__ XcdBarrier xcd_barrier_post(unsigned* bar, volatile LAS unsigned* st) {
    XcdBarrier b; b.bar = bar; b.x = xb_xcc_id(); b.st = st;
    if (threadIdx.x == 0) (void)xb_add(&bar[XB_XCNT(b.x)], 1u);
    return b;
}
__device__ __forceinline__ void xcd_barrier_complete(unsigned* bar, unsigned x, unsigned& nloc, unsigned& nx) {
    const unsigned G = gridDim.x * gridDim.y * gridDim.z;
    unsigned sum, cnt, mine, sp = 0u;
    for (;;) {
        sum = 0u; cnt = 0u; mine = 0u;
#pragma unroll
        for (unsigned j = 0; j < 16; ++j) { const unsigned c = xb_ld(&bar[XB_XCNT(j)]); sum += c; cnt += (c > 0u) ? 1u : 0u; mine = (j == x) ? c : mine; }
        if (sum == G) break;
        __builtin_amdgcn_s_sleep(1);
        if ((++sp & 255u) == 0u) { if (xb_ld(&bar[XB_TMO])) break; if (sp > XB_SPIN_CAP) { atomicAdd(&bar[XB_TMO], 1u); break; } }
    }
    nloc = mine > 0u ? mine : 1u; nx = cnt > 0u ? cnt : 1u;
}
__device__ __forceinline__ void xcd_barrier(const XcdBarrier& b) {
    asm volatile("s_waitcnt vmcnt(0)" ::: "memory");
    __syncthreads();
    if (threadIdx.x == 0) {
        unsigned* bar = b.bar;
        __builtin_amdgcn_s_waitcnt(0);
        unsigned nloc = b.st[0], nx = b.st[1];
        if (nloc == 0u) { xcd_barrier_complete(bar, b.x, nloc, nx); b.st[0] = nloc; b.st[1] = nx; }
        const unsigned old = xb_add(&bar[XB_XSUB(b.x)], 1u);
        const unsigned gen = old / nloc;
        if (old + 1u == (gen + 1u) * nloc) {
            __builtin_amdgcn_fence(__ATOMIC_RELEASE, "agent");
            asm volatile("s_waitcnt vmcnt(0)" ::: "memory");
            const unsigned og = xb_add(&bar[XB_TOP], 1u);
            const unsigned tg = og / nx;
            if (og + 1u == (tg + 1u) * nx) xb_add(&bar[XB_TOPGEN], 1u);
            else XB_SPIN(xb_ld(&bar[XB_TOPGEN]) == tg, bar);
            __builtin_amdgcn_fence(__ATOMIC_ACQUIRE, "agent");
            xb_add(&bar[XB_XGEN(b.x)], 1u);
            asm volatile("s_waitcnt vmcnt(0)" ::: "memory");
        } else {
            XB_SPIN(xb_ld(&bar[XB_XGEN(b.x)]) == gen, bar);
            __builtin_amdgcn_fence(__ATOMIC_ACQUIRE, "agent");
            asm volatile("s_waitcnt vmcnt(0)" ::: "memory");
        }
    }
    __syncthreads();
}

__device__ __forceinline__ int opq_tid() { int t = threadIdx.x; asm volatile("" : "+v"(t)); return t; }
typedef short bf16x8 __attribute__((ext_vector_type(8)));
typedef float f32x4 __attribute__((ext_vector_type(4)));
typedef unsigned u32x2 __attribute__((ext_vector_type(2)));
typedef unsigned u32x4 __attribute__((ext_vector_type(4)));
typedef __bf16 bf16x2v __attribute__((ext_vector_type(2)));
__device__ __forceinline__ u32 pk2(float lo, float hi) { const bf16x2v t = {(__bf16)lo, (__bf16)hi}; return __builtin_bit_cast(u32, t); }
__device__ __forceinline__ uint2 pk4(f32x4 v) { uint2 r; r.x = pk2(v[0], v[1]); r.y = pk2(v[2], v[3]); return r; }
__device__ __forceinline__ int row_mod(int r) { return r < NLAT ? (r >> 12) : 4; }

__device__ __forceinline__ void ph_lnmod(const Params& p, int l, const float* xlat, const float* xctx, int vb, int nblk) {
    const int tidx = opq_tid();
    const int wave = tidx >> 6, lane = tidx & 63;
    const float* mods = (const float*)(p.ws + OFF_MODS) + (size_t)l * 5 * 6144;
    bf16_t* XLN = (bf16_t*)(p.ws + OFF_XLN);
    for (int r = vb * 4 + wave; r < NROWS; r += nblk * 4) {
        const float* src = r < NLAT ? xlat + (size_t)r * 1024 : xctx + (size_t)(r - NLAT) * 1024;
        const float* sh = mods + (size_t)row_mod(r) * 6144; const float* sc = sh + 1024;
        float4 v[4]; float s = 0.f;
#pragma unroll
        for (int j = 0; j < 4; ++j) { v[j] = ((const float4*)src)[lane + 64 * j]; s += (v[j].x + v[j].y) + (v[j].z + v[j].w); }
        const float mean = wave_sum(s) * (1.f / 1024.f); float q = 0.f;
#pragma unroll
        for (int j = 0; j < 4; ++j) { v[j].x -= mean; v[j].y -= mean; v[j].z -= mean; v[j].w -= mean; q += (v[j].x * v[j].x + v[j].y * v[j].y) + (v[j].z * v[j].z + v[j].w * v[j].w); }
        const float rstd = rsqrtf(wave_sum(q) * (1.f / 1024.f) + LN_EPS);
#pragma unroll
        for (int j = 0; j < 4; ++j) {
            const int i0 = (lane + 64 * j) * 4;
            const float4 a = *(const float4*)(sc + i0), b = *(const float4*)(sh + i0);
            ushort4 o;
            o.x = f2bf(v[j].x * rstd * (1.f + a.x) + b.x); o.y = f2bf(v[j].y * rstd * (1.f + a.y) + b.y);
            o.z = f2bf(v[j].z * rstd * (1.f + a.z) + b.z); o.w = f2bf(v[j].w * rstd * (1.f + a.w) + b.w);
            *(ushort4*)(XLN + (size_t)r * 1024 + i0) = o;
        }
    }
}

__device__ __forceinline__ void ph_ln1(const Params& p, int l, int nrows, int vb, int nblk) {
    const int tidx = opq_tid();
    const int wave = tidx >> 6, lane = tidx & 63;
    const float* mods = (const float*)(p.ws + OFF_MODS) + (size_t)l * 5 * 6144;
    const bf16_t* Z = (const bf16_t*)(p.ws + OFF_Z); bf16_t* U = (bf16_t*)(p.ws + OFF_U);
    const float* lg = p.in[19] + l * 1024; const float* lb = p.in[20] + l * 1024;
    const int nw = nblk * 4, w = vb * 4 + wave;
    const int r_lo = (int)(((long long)w * nrows) / nw), r_hi = (int)(((long long)(w + 1) * nrows) / nw);
    f32x4 ga[4], be[4], sc[4], sh[4];
#pragma unroll
    for (int k = 0; k < 4; ++k) { const int i0 = lane * 8 + 512 * (k >> 1) + 4 * (k & 1); ga[k] = *(const f32x4*)(lg + i0); be[k] = *(const f32x4*)(lb + i0); sc[k] = sh[k] = (f32x4){0.f, 0.f, 0.f, 0.f}; }
    int cur = -1;
    for (int r = r_lo; r < r_hi; ++r) {
        const int mi = row_mod(r);
        if (mi != cur) {
            cur = mi; const float* shp = mods + (size_t)mi * 6144 + 3072;
#pragma unroll
            for (int k = 0; k < 4; ++k) { const int i0 = lane * 8 + 512 * (k >> 1) + 4 * (k & 1); sh[k] = *(const f32x4*)(shp + i0); sc[k] = *(const f32x4*)(shp + 1024 + i0) + 1.f; }
        }
        const uint4 t0 = *(const uint4*)(Z + (size_t)r * 1024 + lane * 8), t1 = *(const uint4*)(Z + (size_t)r * 1024 + 512 + lane * 8);
        f32x4 v[4];
        v[0] = (f32x4){__uint_as_float(t0.x << 16), __uint_as_float(t0.x & 0xffff0000u), __uint_as_float(t0.y << 16), __uint_as_float(t0.y & 0xffff0000u)};
        v[1] = (f32x4){__uint_as_float(t0.z << 16), __uint_as_float(t0.z & 0xffff0000u), __uint_as_float(t0.w << 16), __uint_as_float(t0.w & 0xffff0000u)};
        v[2] = (f32x4){__uint_as_float(t1.x << 16), __uint_as_float(t1.x & 0xffff0000u), __uint_as_float(t1.y << 16), __uint_as_float(t1.y & 0xffff0000u)};
        v[3] = (f32x4){__uint_as_float(t1.z << 16), __uint_as_float(t1.z & 0xffff0000u), __uint_as_float(t1.w << 16), __uint_as_float(t1.w & 0xffff0000u)};
        float s = 0.f;
#pragma unroll
        for (int k = 0; k < 4; ++k) s += (v[k][0] + v[k][1]) + (v[k][2] + v[k][3]);
        float mean = wave_sum(s) * (1.f / 1024.f); float q = 0.f;
#pragma unroll
        for (int k = 0; k < 4; ++k) { v[k] = v[k] - mean; q += (v[k][0] * v[k][0] + v[k][1] * v[k][1]) + (v[k][2] * v[k][2] + v[k][3] * v[k][3]); }
        float rstd = rsqrtf(wave_sum(q) * (1.f / 1024.f) + LN_EPS);
        s = 0.f;
#pragma unroll
        for (int k = 0; k < 4; ++k) { v[k] = v[k] * rstd * ga[k] + be[k]; s += (v[k][0] + v[k][1]) + (v[k][2] + v[k][3]); }
        mean = wave_sum(s) * (1.f / 1024.f); q = 0.f;
#pragma unroll
        for (int k = 0; k < 4; ++k) { v[k] = v[k] - mean; q += (v[k][0] * v[k][0] + v[k][1] * v[k][1]) + (v[k][2] * v[k][2] + v[k][3] * v[k][3]); }
        rstd = rsqrtf(wave_sum(q) * (1.f / 1024.f) + LN_EPS);
#pragma unroll
        for (int k = 0; k < 4; ++k) v[k] = v[k] * rstd * sc[k] + sh[k];
        const uint2 o0 = pk4(v[0]), o1 = pk4(v[1]), o2 = pk4(v[2]), o3 = pk4(v[3]);
        *(uint4*)(U + (size_t)r * 1024 + lane * 8) = make_uint4(o0.x, o0.y, o1.x, o1.y); *(uint4*)(U + (size_t)r * 1024 + 512 + lane * 8) = make_uint4(o2.x, o2.y, o3.x, o3.y);
    }
}


__device__ __forceinline__ int perm64(int q) { return (q & ~63) | (q & 3) | (((q >> 4) & 3) << 2) | (((q >> 2) & 3) << 4); }
template <bool BATCH>
__device__ __forceinline__ void prep_transpose(const float* W, int ldw, bf16_t* WT, int ldk, int k0, int n0, int nout0, float* scr, bool perm) {
    const int tid = opq_tid();
    __syncthreads();
    if (BATCH) {
        float tv[16];
#pragma unroll
        for (int i = 0; i < 16; ++i) tv[i] = W[(size_t)(k0 + i * 4 + (tid >> 6)) * ldw + n0 + (tid & 63)];
#pragma unroll
        for (int i = 0; i < 16; ++i) scr[(i * 4 + (tid >> 6)) * 65 + (tid & 63)] = tv[i];
    } else {
#pragma unroll 4
        for (int i = 0; i < 16; ++i) { const int kk = i * 4 + (tid >> 6), c = tid & 63; scr[kk * 65 + c] = W[(size_t)(k0 + kk) * ldw + n0 + c]; }
    }
    __syncthreads();
    const int n = tid >> 2, kq = (tid & 3) * 16;
    uint4 o0, o1;
    o0.x = pk2(scr[(kq + 0) * 65 + n], scr[(kq + 1) * 65 + n]); o0.y = pk2(scr[(kq + 2) * 65 + n], scr[(kq + 3) * 65 + n]);
    o0.z = pk2(scr[(kq + 4) * 65 + n], scr[(kq + 5) * 65 + n]); o0.w = pk2(scr[(kq + 6) * 65 + n], scr[(kq + 7) * 65 + n]);
    o1.x = pk2(scr[(kq + 8) * 65 + n], scr[(kq + 9) * 65 + n]); o1.y = pk2(scr[(kq + 10) * 65 + n], scr[(kq + 11) * 65 + n]);
    o1.z = pk2(scr[(kq + 12) * 65 + n], scr[(kq + 13) * 65 + n]); o1.w = pk2(scr[(kq + 14) * 65 + n], scr[(kq + 15) * 65 + n]);
    bf16_t* dst = WT + (size_t)(nout0 + (perm ? perm64(n) : n)) * ldk + k0 + kq;
    *(uint4*)dst = o0; *(uint4*)(dst + 8) = o1;
}
__device__ __forceinline__ void prep_convert8k(const float* src, bf16_t* dst) {
#pragma unroll
    for (int rep = 0; rep < 4; ++rep) {
        const size_t e = ((size_t)rep * 256 + opq_tid()) * 8;
        const float4 a = *(const float4*)(src + e), b = *(const float4*)(src + e + 4);
        uint4 o; o.x = pk2(a.x, a.y); o.y = pk2(a.z, a.w); o.z = pk2(b.x, b.y); o.w = pk2(b.z, b.w);
        *(uint4*)(dst + e) = o;
    }
}
#define PREP_TAB_OFF 65536
__device__ __forceinline__ void prep_tables(unsigned char* ldsg) {
    float* tabh = (float*)(ldsg + PREP_TAB_OFF); float* c64 = tabh + 2048; float* s64 = c64 + 64;
    const int tid = opq_tid();
    __syncthreads();
    for (int m = tid; m < 2048; m += NTHREADS) tabh[m] = __cosf((float)m * 0.0015339807878856412f);
    if (tid < 64) { c64[tid] = __cosf((float)tid * 0.09817477042468103f); s64[tid] = __sinf((float)tid * 0.09817477042468103f); }
    __syncthreads();
}
__device__ __forceinline__ float tab_cos(const float* tabh, int m) { m &= 4095; return m < 2048 ? tabh[m] : -tabh[m - 2048]; }

#define PREPA_N1 3072
#define PREPA_N2 512
#define PREPA_N3 2
#define PREPA_N4 384
#define PREPA_TOTAL (PREPA_N1 + PREPA_N2 + PREPA_N3 + PREPA_N4)
#define PREP_SILU_OFF 20480
__device__ __forceinline__ void prep_item_a(const Params& p, int r, unsigned char* ldsg) {
    float* scr = (float*)ldsg;
    const float* c64 = (const float*)(ldsg + PREP_TAB_OFF) + 2048; const float* s64 = c64 + 64;
    const int tid = opq_tid();
    bf16_t* WINT = (bf16_t*)(p.ws + OFF_WINT); float* BINP = (float*)(p.ws + OFF_BINP);
    if (r < PREPA_N1) {
        const int l = r / 1536; r -= l * 1536; const int kt = r / 96, j = r % 96;
        const int o = j < 20 ? j : j + 4; const int n0 = o * 64; const int nout0 = o < 20 ? n0 : n0 + 256;
        prep_transpose<true>(p.in[6] + (size_t)l * 1024 * INTOT, INTOT, WINT + (size_t)l * 6656 * 1024, 1024, kt * 64, n0, nout0, scr, nout0 < 1024 || nout0 >= 2560);
        return;
    } r -= PREPA_N1;
    if (r < PREPA_N2) {
        const int l = r >> 8; const int kt = (r >> 4) & 15, g = (r >> 2) & 3, jp = r & 3;
        const float* W = p.in[6] + (size_t)l * 1024 * INTOT;
        __syncthreads();
        float tv[16];
#pragma unroll
        for (int i = 0; i < 16; ++i) tv[i] = W[(size_t)(kt * 64 + i * 4 + (tid >> 6)) * INTOT + 1280 + g * 64 + (tid & 63)];
#pragma unroll
        for (int i = 0; i < 16; ++i) scr[(i * 4 + (tid >> 6)) * 65 + (tid & 63)] = tv[i];
        __syncthreads();
        const int kk = tid & 63, jq = tid >> 6;
        bf16_t* wt = WINT + (size_t)l * 6656 * 1024 + kt * 64 + kk;
#pragma unroll
        for (int jj = 0; jj < 4; ++jj) {
            const int j = jp * 16 + jq * 4 + jj; float hc = 0.f, hs = 0.f;
#pragma unroll 8
            for (int c = 0; c < 64; ++c) { const float x = scr[kk * 65 + c]; const int m = (j * c) & 63; hc += x * c64[m]; hs += x * s64[m]; }
            wt[(size_t)(1280 + g * 64 + j) * 1024] = f2bf(hc); wt[(size_t)(1536 + g * 64 + j) * 1024] = f2bf(hs);
        }
        return;
    } r -= PREPA_N2;
    if (r < PREPA_N3) {
        const int l = r; const float* b = p.in[7] + (size_t)l * INTOT;
        for (int n = tid; n < 6656; n += NTHREADS) {
            float v;
            const int nl = (n < 1024 || n >= 2560) ? perm64(n) : n;
            if (n < 1280) v = b[nl];
            else if (n < 1792) { const int sc = n >= 1536; const int q = (n - 1280) & 255; const int g = q >> 6, j = q & 63; float a = 0.f;
                for (int c = 0; c < 64; ++c) a += b[1280 + g * 64 + c] * (sc ? s64[(j * c) & 63] : c64[(j * c) & 63]);
                v = a; }
            else v = b[nl - 256];
            BINP[(size_t)l * 6656 + n] = v;
        }
        return;
    } r -= PREPA_N3;
    {
        const float* sl = (const float*)(ldsg + PREP_SILU_OFF);
        const int cl = tid & 31, ks = tid >> 5;
        const int col = r * 32 + cl; const int l = col / 6144, n = col % 6144;
        const float* W = p.in[4] + (size_t)l * 1024 * 6144 + n;
        float a0 = 0.f, a1 = 0.f, a2 = 0.f, a3 = 0.f, a4 = 0.f;
#pragma unroll 32
        for (int k = ks * 128; k < ks * 128 + 128; ++k) {
            const float w = W[(size_t)k * 6144];
            a0 += sl[k] * w; a1 += sl[1024 + k] * w; a2 += sl[2048 + k] * w; a3 += sl[3072 + k] * w; a4 += sl[4096 + k] * w;
        }
        __syncthreads();
        scr[(ks * 5 + 0) * 32 + cl] = a0; scr[(ks * 5 + 1) * 32 + cl] = a1; scr[(ks * 5 + 2) * 32 + cl] = a2; scr[(ks * 5 + 3) * 32 + cl] = a3; scr[(ks * 5 + 4) * 32 + cl] = a4;
        __syncthreads();
        if (tid < 160) {
            const int q = tid >> 5, c2 = tid & 31; const int col2 = r * 32 + c2; const int l2 = col2 / 6144, n2 = col2 % 6144;
            float v = p.in[5][l2 * 6144 + n2];
#pragma unroll
            for (int k8 = 0; k8 < 8; ++k8) v += scr[(k8 * 5 + q) * 32 + c2];
            ((float*)(p.ws + OFF_MODS))[((size_t)l2 * 5 + q) * 6144 + n2] = v;
        }
    }
}
__device__ __forceinline__ void ph_prep_fast(const Params& p, unsigned char* ldsg, int vb, int nblk) {
    prep_tables(ldsg);
    {
        float* sl = (float*)(ldsg + PREP_SILU_OFF);
        for (int i = opq_tid(); i < 5 * 1024; i += NTHREADS) sl[i] = silu_f(i < 4096 ? p.in[1][i] : p.in[3][i - 4096]);
        __syncthreads();
    }
    for (int item = vb; item < PREPA_TOTAL; item += nblk) prep_item_a(p, item, ldsg);
}

#define PREPB_N1 640
#define PREPB_N2 512
#define PREPB_N3 1024
#define PREPB_N4 64
#define PREPB_N8 2
#define PREPB_N6 16
#define PREPB_N7 4096
#define PREPB_TOTAL (PREPB_N1 + PREPB_N2 + PREPB_N3 + PREPB_N4 + PREPB_N6 + PREPB_N8)
#define EU_SCALE 64.f
#define EV_SCALE 4.f
typedef float f32x2 __attribute__((ext_vector_type(2)));
#define EXPERT_BITS 6
#ifndef EU_BITS
#define EU_BITS 6
#endif
#ifndef EV_BITS
#define EV_BITS 4
#endif
#define EXP_ROWB 768
typedef __bf16 bf16x32v __attribute__((ext_vector_type(32)));
typedef float f32x32v __attribute__((ext_vector_type(32)));
typedef unsigned u32x6v __attribute__((ext_vector_type(6)));
typedef unsigned u32x3v __attribute__((ext_vector_type(3)));
__device__ __forceinline__ void prep_euv_item(const Params& p, int l, int it) {
    unsigned char* EUV = p.ws + OFF_EUV;
    const int tbl = it >> 11; const size_t e0 = (size_t)(it & 2047) * 8192;
    const float* src = (tbl == 0 ? p.in[24] : p.in[25]) + (size_t)l * 16384 * 1024 + e0;
    const float sc = tbl == 0 ? EU_SCALE : EV_SCALE;
    const size_t e = (size_t)opq_tid() * 32;
    const size_t el = e0 + e; const int jl = (int)(el >> 5) & 31;
    const int bits = tbl == 0 ? EU_BITS : EV_BITS;
    unsigned char* dst = EUV + (size_t)(l * 2 + tbl) * 16384 * EXP_ROWB + (el >> 10) * (size_t)(bits * 128);
    float x[32];
#pragma unroll
    for (int q = 0; q < 8; ++q) { const float4 v = *(const float4*)(src + e + 4 * q); x[4 * q] = v.x * sc; x[4 * q + 1] = v.y * sc; x[4 * q + 2] = v.z * sc; x[4 * q + 3] = v.w * sc; }
    if (bits == 6) {
        bf16x32v hb;
#pragma unroll
        for (int q = 0; q < 32; ++q) hb[q] = (__bf16)x[q];
        const u32x6v w = __builtin_amdgcn_cvt_scalef32_pk32_fp6_bf16(hb, 1.0f);
        *(uint4*)(dst + 16 * jl) = make_uint4(w[0], w[1], w[2], w[3]); *(uint2*)(dst + 512 + 8 * jl) = make_uint2(w[4], w[5]);
    } else {
        u32 w[4];
#pragma unroll
        for (int q = 0; q < 4; ++q) {
            u32 t = 0u;
            t = __builtin_amdgcn_cvt_scalef32_pk_fp4_f32(t, x[8 * q + 0], x[8 * q + 1], 1.0f, 0);
            t = __builtin_amdgcn_cvt_scalef32_pk_fp4_f32(t, x[8 * q + 2], x[8 * q + 3], 1.0f, 1);
            t = __builtin_amdgcn_cvt_scalef32_pk_fp4_f32(t, x[8 * q + 4], x[8 * q + 5], 1.0f, 2);
            t = __builtin_amdgcn_cvt_scalef32_pk_fp4_f32(t, x[8 * q + 6], x[8 * q + 7], 1.0f, 3);
            w[q] = t;
        }
        *(uint4*)(dst + 16 * jl) = make_uint4(w[0], w[1], w[2], w[3]);
    }
}
__device__ __forceinline__ void prep_item_b(const Params& p, int r, unsigned char* ldsg, int scr_off) {
    float* scr = (float*)(ldsg + scr_off);
    const float* tabh = (const float*)(ldsg + PREP_TAB_OFF);
    const int tid = opq_tid();
    bf16_t* WBRT = (bf16_t*)(p.ws + OFF_WBRT); bf16_t* WOT = (bf16_t*)(p.ws + OFF_WOT); bf16_t* WQT = (bf16_t*)(p.ws + OFF_WQT);
    bf16_t* K12 = (bf16_t*)(p.ws + OFF_K12); bf16_t* TWC = (bf16_t*)(p.ws + OFF_TWC);
    if (r < PREPB_N1) {
        const int l = r / 320; r -= l * 320;
        int br, kt, nt;
        if (r < 192) { br = r >> 6; kt = (r & 63) >> 4; nt = r & 15; } else { br = 3; r -= 192; kt = r >> 4; nt = r & 15; }
        const int K = br < 3 ? 256 : 512;
        const float* W = (br == 0 ? p.in[14] : (br == 1 ? p.in[15] : (br == 2 ? p.in[16] : p.in[17]))) + (size_t)l * K * 1024;
        prep_transpose<false>(W, 1024, WBRT + (size_t)l * WBRT_L + (size_t)br * 1024 * 256, K, kt * 64, nt * 64, nt * 64, scr, true);
        return;
    } r -= PREPB_N1;
    if (r < PREPB_N2) { const int l = r >> 8; const int kt = (r >> 4) & 15, nt = r & 15;
        prep_transpose<false>(p.in[18] + (size_t)l * 1024 * 1024, 1024, WOT + (size_t)l * 1024 * 1024, 1024, kt * 64, nt * 64, nt * 64, scr, true); return; } r -= PREPB_N2;
    if (r < PREPB_N3) { const int l = r >> 9; const int kt = (r >> 5) & 15, nt = r & 31;
        prep_transpose<false>(p.in[21] + (size_t)l * 1024 * 2048, 2048, WQT + (size_t)l * 2048 * 1024, 1024, kt * 64, nt * 64, nt * 64, scr, false); return; } r -= PREPB_N3;
    if (r < PREPB_N4) { const int tbl = r >> 5; const size_t e0 = (size_t)(r & 31) * 8192;
        prep_convert8k((tbl == 0 ? p.in[22] : p.in[23]) + e0, K12 + (size_t)tbl * 262144 + e0); return; } r -= PREPB_N4;
    if (r < PREPB_N6) {
        const int k = r * 16 + (tid >> 4); const int t0 = (tid & 15) * 16; bf16_t* row = TWC + (size_t)k * 512;
        for (int e = 0; e < 16; ++e) { const int m = k * (t0 + e) * 16; row[t0 + e] = f2bf(tab_cos(tabh, m) * (1.f / 128.f)); row[256 + t0 + e] = f2bf(-tab_cos(tabh, m + 3072) * (1.f / 128.f)); }
        return;
    } r -= PREPB_N6;
    if (r < PREPB_N8) {
        const float* c64 = tabh + 2048; const float* s64 = c64 + 64;
        if (r == 0) {
            bf16_t* B1 = (bf16_t*)(p.ws + OFF_FB1);
            for (int i = tid; i < 128 * 128; i += NTHREADS) {
                const int n = i >> 7, k = i & 127; const int d = n >> 1, part = n & 1; const int m = ((k & 63) * d) & 63;
                float v;
                if (part == 0) v = k < 64 ? c64[m] : -s64[m];
                else v = k < 64 ? -s64[m] : -c64[m];
                B1[i] = f2bf(v);
            }
        } else {
            bf16_t* B3 = (bf16_t*)(p.ws + OFF_FB3);
            for (int i = tid; i < 64 * 128; i += NTHREADS) {
                const int c = i >> 7, k = i & 127; const int m = ((k & 63) * c) & 63;
                B3[i] = f2bf((k < 64 ? c64[m] : s64[m]) * (1.f / 512.f));
            }
        }
        return;
    }
}

__device__ __forceinline__ const char* uniform_ptr(const char* q) {
    const unsigned long long v = (unsigned long long)q;
    const u32 lo = __builtin_amdgcn_readfirstlane((u32)v), hi = __builtin_amdgcn_readfirstlane((u32)(v >> 32));
    return (const char*)(((unsigned long long)hi << 32) | lo);
}
#define GEMM_LDS_BYTES 65536
template <bool TR, int NI = 4, int PERMA = 0>
__device__ __forceinline__ void gemm_tile(f32x4 (&acc)[4][NI], const bf16_t* A, int lda, const bf16_t* Bt, int ldb, int K, LAS unsigned char* lds,
                                          bool pre = false, const bf16_t* nA = nullptr, int nlda = 0, const bf16_t* nBt = nullptr, int nldb = 0, bool nperm = false) {
    const int tid = opq_tid(), lane = tid & 63;
    const int wave = __builtin_amdgcn_readfirstlane(tid >> 6);
    const int wr = wave >> 1, wc = wave & 1, fr = lane & 15, fq = lane >> 4;
    const int srow = lane >> 3, sch = (lane & 7) ^ (lane >> 3);
    unsigned offA[4], offB[4];
#pragma unroll
    for (int i = 0; i < 4; ++i) { const int r0_ = 32 * wave + 8 * i + srow; const int r = PERMA == 1 ? (r0_ >> 6) + 64 * perm64(r0_ & 63) : (PERMA == 2 ? perm64(r0_) : r0_);
        offA[i] = (unsigned)(r * lda + sch * 8) * 2u; const int rb = 8 * NI * wave + 8 * i + srow; offB[i] = (unsigned)(rb * ldb + sch * 8) * 2u; }
    const int nk = K >> 6;
    const int aoff = (wr * 64 + fr) * 128, boff = 16384 + (wc * 16 * NI + fr) * 128;
    const int x0 = ((0 + fq) ^ (fr & 7)) << 4, x1 = ((4 + fq) ^ (fr & 7)) << 4;
#pragma unroll
    for (int mi = 0; mi < 4; ++mi)
#pragma unroll
        for (int ni = 0; ni < NI; ++ni) acc[mi][ni] = (f32x4){0.f, 0.f, 0.f, 0.f};
#define GEMM_STAGE(s, kt) do { \
        const char* ga_ = uniform_ptr((const char*)A + (size_t)(kt) * 128); const char* gb_ = uniform_ptr((const char*)Bt + (size_t)(kt) * 128); \
        LAS unsigned char* la_ = lds + (s) * 32768 + wave * 4096; \
        LAS unsigned char* lb_ = lds + (s) * 32768 + 16384 + wave * (NI * 1024); \
        _Pragma("unroll") for (int i_ = 0; i_ < 4; ++i_) { \
            __builtin_amdgcn_global_load_lds((const unsigned*)(ga_ + offA[i_]), (LAS unsigned*)(la_ + i_ * 1024), 16, 0, 0); \
            if (i_ < NI) __builtin_amdgcn_global_load_lds((const unsigned*)(gb_ + offB[i_]), (LAS unsigned*)(lb_ + i_ * 1024), 16, 0, 0); } } while (0)
    if (!pre) {
        __syncthreads();
        GEMM_STAGE(0, 0);
    }
    bf16x8 a0[4], b0[NI], a1[4], b1[NI];
#define GEMM_RD(av, bv, base_, xo_) do { \
        _Pragma("unroll") for (int mi = 0; mi < 4; ++mi) av[mi] = *(const LAS bf16x8*)((base_) + aoff + mi * 2048 + (xo_)); \
        _Pragma("unroll") for (int ni = 0; ni < NI; ++ni) bv[ni] = *(const LAS bf16x8*)((base_) + boff + ni * 2048 + (xo_)); } while (0)
#define GEMM_MM(av, bv) do { \
        _Pragma("unroll") for (int mi = 0; mi < 4; ++mi) \
        _Pragma("unroll") for (int ni = 0; ni < NI; ++ni) \
            acc[mi][ni] = TR ? __builtin_amdgcn_mfma_f32_16x16x32_bf16(bv[ni], av[mi], acc[mi][ni], 0, 0, 0) \
                             : __builtin_amdgcn_mfma_f32_16x16x32_bf16(av[mi], bv[ni], acc[mi][ni], 0, 0, 0); } while (0)
#define GEMM_SCHED_RD() do { \
        _Pragma("unroll") for (int i_ = 0; i_ < 4 + NI; ++i_) { __builtin_amdgcn_sched_group_barrier(0x008, 2, 0); __builtin_amdgcn_sched_group_barrier(0x100, 1, 0); } \
        __builtin_amdgcn_sched_group_barrier(0x008, 4 * NI - 2 * (4 + NI) > 0 ? 4 * NI - 2 * (4 + NI) : 0, 0); __builtin_amdgcn_sched_barrier(0); } while (0)
#define GEMM_SCHED_VM_RD() do { \
        _Pragma("unroll") for (int i_ = 0; i_ < 4 + NI; ++i_) { __builtin_amdgcn_sched_group_barrier(0x008, 1, 0); __builtin_amdgcn_sched_group_barrier(0x020, 1, 0); \
                                                                 __builtin_amdgcn_sched_group_barrier(0x008, 1, 0); __builtin_amdgcn_sched_group_barrier(0x100, 1, 0); } \
        __builtin_amdgcn_sched_group_barrier(0x008, 4 * NI - 2 * (4 + NI) > 0 ? 4 * NI - 2 * (4 + NI) : 0, 0); __builtin_amdgcn_sched_barrier(0); } while (0)
#define GEMM_MIDBAR() do { asm volatile("s_waitcnt vmcnt(0) lgkmcnt(0)" ::: "memory"); __builtin_amdgcn_s_barrier(); asm volatile("" ::: "memory"); } while (0)
    asm volatile("s_waitcnt vmcnt(0)" ::: "memory");
    __syncthreads();
    GEMM_STAGE(1, 1);
    GEMM_RD(a0, b0, lds, x0);
    for (int kt = 0; kt + 2 < nk; ++kt) {
        const LAS unsigned char* base = lds + (kt & 1) * 32768; const LAS unsigned char* nbase = lds + ((kt + 1) & 1) * 32768;
        GEMM_RD(a1, b1, base, x1);
        GEMM_MM(a0, b0);
        GEMM_SCHED_RD();
        GEMM_MIDBAR();
        GEMM_STAGE(kt & 1, kt + 2);
        GEMM_RD(a0, b0, nbase, x0);
        GEMM_MM(a1, b1);
        GEMM_SCHED_VM_RD();
    }
    {
        GEMM_RD(a1, b1, lds, x1);
        GEMM_MM(a0, b0);
        GEMM_SCHED_RD();
        GEMM_MIDBAR();
        if (nA != nullptr) {
            const char* ga_ = uniform_ptr((const char*)nA); const char* gb_ = uniform_ptr((const char*)nBt);
            LAS unsigned char* la_ = lds + wave * 4096; LAS unsigned char* lb_ = lds + 16384 + wave * (NI * 1024);
#pragma unroll
            for (int i_ = 0; i_ < 4; ++i_) {
                const int r0_ = 32 * wave + 8 * i_ + srow, rb_ = 8 * NI * wave + 8 * i_ + srow; const int r_ = nperm ? perm64(r0_) : r0_;
                __builtin_amdgcn_global_load_lds((const unsigned*)(ga_ + (unsigned)(r_ * nlda + sch * 8) * 2u), (LAS unsigned*)(la_ + i_ * 1024), 16, 0, 0);
                if (i_ < NI) __builtin_amdgcn_global_load_lds((const unsigned*)(gb_ + (unsigned)(rb_ * nldb + sch * 8) * 2u), (LAS unsigned*)(lb_ + i_ * 1024), 16, 0, 0);
            }
        }
        GEMM_RD(a0, b0, lds + 32768, x0);
        GEMM_MM(a1, b1);
        GEMM_SCHED_RD();
    }
    {
        GEMM_RD(a1, b1, lds + 32768, x1);
        GEMM_MM(a0, b0);
        GEMM_SCHED_RD();
        GEMM_MM(a1, b1);
    }
#undef GEMM_RD
#undef GEMM_MM
#undef GEMM_SCHED_RD
#undef GEMM_SCHED_VM_RD
#undef GEMM_MIDBAR
#undef GEMM_STAGE
}

__device__ __forceinline__ bool tile_sched(int it, int vb, int nM, int nN, int& m, int& n) {
    const int x = vb & 7, j = vb >> 3, nbx = (int)gridDim.x >> 3, mper = nM >> 3;
    int lt = it * nbx + j;
    if (lt >= mper * nN) return false;
    const int nchunk = mper >= 16 ? (mper >> 3) : 1; const int cs = mper / nchunk;
    int ci = lt / (cs * nN); if (ci >= nchunk) ci = nchunk - 1;
    lt -= ci * cs * nN;
    const int csi = ci == nchunk - 1 ? mper - ci * cs : cs;
    n = lt / csi; m = x * mper + ci * cs + (lt - n * csi);
    return true;
}
__device__ __forceinline__ void ph_inproj_fast(const Params& p, int l, unsigned char* ldsg, int vb, int nblk) {
    LAS unsigned char* lds = (LAS unsigned char*)ldsg;
    if (l == 0) prep_tables(ldsg);
    int slot = 0; const int nextra = l == 0 ? PREPB_TOTAL : 0; const int per_tile = 1;
    const bf16_t* XLN = (const bf16_t*)(p.ws + OFF_XLN);
    const bf16_t* WT = (const bf16_t*)(p.ws + OFF_WINT) + (size_t)l * 6656 * 1024;
    const float* bias = (const float*)(p.ws + OFF_BINP) + (size_t)l * 6656;
    bf16_t* PL = (bf16_t*)(p.ws + OFF_PL);
    const int tidx = opq_tid(); const int lane = tidx & 63, wave = tidx >> 6, wr = wave >> 1, wc = wave & 1, fr = lane & 15, fq = lane >> 4;
    const int nctx = l == 0 ? 52 : 6;
    auto sched = [&](int it, int& m_, int& n_, int& kind_) -> bool {
        kind_ = 0;
        if (tile_sched(it, vb, NLAT / 128, 48, m_, n_)) { if (n_ >= 10) n_ += 4; return true; }
        int lt = it * (nblk >> 3) + (vb >> 3) - NLAT / 128 / 8 * 48;
        if (lt < nctx) { m_ = NLAT / 128 + (vb & 7); n_ = l == 0 ? lt : (lt < 4 ? 6 + lt : 14 + lt); return true; }
        lt -= nctx;
        if (lt < 64) { m_ = (vb & 7) * 16 + (lt >> 2); n_ = 10 + (lt & 3); kind_ = 1; return true; }
        return false;
    };
    int m, n, kind; bool have = sched(0, m, n, kind); bool pre = false;
    for (int it = 0; have; ++it) {
        int mn = 0, nn = 0, kindn = 0; const bool have_next = sched(it + 1, mn, nn, kindn);
        const bool chain = have_next && kindn == 0;
        const bool nntr = (nn >= 8 && nn < 14) || nn == 19;
        const bf16_t* nA = chain ? XLN + (size_t)mn * 128 * 1024 : nullptr; const bf16_t* nB = chain ? WT + (size_t)nn * 128 * 1024 : nullptr;
        f32x4 acc[4][4];
        if (kind == 1) {
            const int b = m >> 5, a0 = (m & 31) * 2, n0 = n * 128;
            gemm_tile<false, 4, 1>(acc, XLN + ((size_t)b * 4096 + a0) * 1024, 1024, WT + (size_t)n0 * 1024, 1024, 1024, lds, pre, nA, 1024, nB, 1024, nntr);
#pragma unroll
            for (int ni = 0; ni < 4; ++ni) {
                const int ncol = n0 + wc * 64 + ni * 16 + fr; const float bn = bias[ncol];
                const int c = (ncol - 1280) & 255, part = ncol >= 1536;
                bf16_t* h2 = (bf16_t*)(p.ws + OFF_HT2) + (((size_t)b * 256 + c) * 64 + a0 + wr) * 128 + part * 64 + 16 * fq;
                const uint2 s0 = pk4(acc[0][ni] + bn), s1 = pk4(acc[1][ni] + bn), s2 = pk4(acc[2][ni] + bn), s3 = pk4(acc[3][ni] + bn);
                *(uint4*)h2 = make_uint4(s0.x, s0.y, s1.x, s1.y); *(uint4*)(h2 + 8) = make_uint4(s2.x, s2.y, s3.x, s3.y);
            }
            for (int k = 0; k < per_tile; ++k, ++slot) { const int item = slot * nblk + vb; if (item < nextra) { prep_item_b(p, item, ldsg, 32768); } }
            pre = chain; have = have_next; m = mn; n = nn; kind = kindn;
            continue;
        }
        const int m0 = m * 128, n0 = n * 128;
        const bool lat = m0 < NLAT;
        const bool ntr = (n0 >= 1024 && n0 < 1792) || (n0 >= 2432 && n0 < 2560);
        if (!ntr) {
            f32x4 bv[4];
#pragma unroll
            for (int ni = 0; ni < 4; ++ni) bv[ni] = *(const f32x4*)(bias + n0 + wc * 64 + ni * 16 + 4 * fq);
            gemm_tile<true>(acc, XLN + (size_t)m0 * 1024, 1024, WT + (size_t)n0 * 1024, 1024, 1024, lds, pre, nA, 1024, nB, 1024, nntr);
            int pc, mode;
            if (n0 < 1024) { pc = n0; mode = 0; }
            else if (n0 < 2304) { pc = PL_GQ + (n0 - 1792); mode = 1; }
            else if (n0 < 2432) { pc = PL_GK + (n0 - 2304); mode = 1; }
            else { pc = 0; mode = 2; }
            pc += wc * 64 + 16 * fq;
            float fre[4];
#pragma unroll
            for (int e = 0; e < 4; ++e) fre[e] = exp2f(-(float)(4 * fq + e) * (13.287712379549449f / 16.f));
#pragma unroll
            for (int mi = 0; mi < 4; ++mi) {
                const int row = m0 + wr * 64 + mi * 16 + fr;
                f32x4 v[4];
#pragma unroll
                for (int ni = 0; ni < 4; ++ni) v[ni] = acc[mi][ni] + bv[ni];
                if (mode == 1 && lat) {
                    const int t = row & 4095; const float pr = (float)(t >> 6), pcl = (float)(t & 63);
#pragma unroll
                    for (int e = 0; e < 4; ++e) {
                        float sn, cs; sincos_red(pr * fre[e], sn, cs);
                        const float x1 = v[0][e], x2 = v[1][e]; v[0][e] = x1 * cs - x2 * sn; v[1][e] = x1 * sn + x2 * cs;
                        sincos_red(pcl * fre[e], sn, cs);
                        const float y1 = v[2][e], y2 = v[3][e]; v[2][e] = y1 * cs - y2 * sn; v[3][e] = y1 * sn + y2 * cs;
                    }
                }
                if (mode == 2) {
                    unsigned char* g8 = p.ws + OFF_G8 + (size_t)row * 4096 + (n0 - 2560) + wc * 64 + 16 * fq;
                    u32x4 w4;
#pragma unroll
                    for (int ni = 0; ni < 4; ++ni) {
                        u32 w = 0u;
#pragma unroll
                        for (int e = 0; e < 4; ++e) w = __builtin_amdgcn_cvt_pk_u8_f32(sigmoid_f(v[ni][e]) * 255.f, e, w);
                        w4[ni] = w;
                    }
                    *(u32x4*)g8 = w4;
                } else {
                    const uint2 s0 = pk4(v[0]), s1 = pk4(v[1]), s2 = pk4(v[2]), s3 = pk4(v[3]);
                    *(uint4*)(PL + (size_t)row * PLW + pc) = make_uint4(s0.x, s0.y, s1.x, s1.y); *(uint4*)(PL + (size_t)row * PLW + pc + 8) = make_uint4(s2.x, s2.y, s3.x, s3.y);
                }
            }
        } else {
            gemm_tile<false, 4, 2>(acc, XLN + (size_t)m0 * 1024, 1024, WT + (size_t)n0 * 1024, 1024, 1024, lds, pre, nA, 1024, nB, 1024, nntr);
            const int b = lat ? (m0 >> 12) : ((m0 - NLAT) >> 8);
            const int tb = (lat ? (m0 & 4095) : ((m0 - NLAT) & 255)) + wr * 64 + 16 * fq;
#pragma unroll
            for (int ni = 0; ni < 4; ++ni) {
                const int ncol = n0 + wc * 64 + ni * 16 + fr; const float bn = bias[ncol];
                bf16_t* dst;
                if (ncol < 1280) { const int c = perm64(ncol - 1024); dst = lat ? (bf16_t*)(p.ws + OFF_NVT) + ((size_t)b * 256 + c) * 4096 : (bf16_t*)(p.ws + OFF_NVTC) + ((size_t)b * 256 + c) * 256; }
                else if (ncol < 1536) { const int c = ncol - 1280; dst = lat ? (bf16_t*)(p.ws + OFF_HT) + ((size_t)b * 256 + c) * 8192 : (bf16_t*)(p.ws + OFF_HTC) + ((size_t)b * 256 + c) * 512; }
                else if (ncol < 1792) { const int c = ncol - 1536; dst = lat ? (bf16_t*)(p.ws + OFF_HT) + ((size_t)b * 256 + c) * 8192 + 4096 : (bf16_t*)(p.ws + OFF_HTC) + ((size_t)b * 256 + c) * 512 + 256; }
                else { const int c = perm64(ncol - 2432); dst = lat ? (bf16_t*)(p.ws + OFF_GVT) + ((size_t)b * 128 + c) * 4096 : (bf16_t*)(p.ws + OFF_GVTC) + ((size_t)b * 128 + c) * 256; }
                const uint2 s0 = pk4(acc[0][ni] + bn), s1 = pk4(acc[1][ni] + bn), s2 = pk4(acc[2][ni] + bn), s3 = pk4(acc[3][ni] + bn);
                *(uint4*)(dst + tb) = make_uint4(s0.x, s0.y, s1.x, s1.y); *(uint4*)(dst + tb + 8) = make_uint4(s2.x, s2.y, s3.x, s3.y);
            }
        }
        for (int k = 0; k < per_tile; ++k, ++slot) { const int item = slot * nblk + vb; if (item < nextra) { prep_item_b(p, item, ldsg, 32768); } }
        pre = chain; have = have_next; m = mn; n = nn; kind = kindn;
    }
    for (; slot * nblk + vb < nextra; ++slot) { const int item = slot * nblk + vb; prep_item_b(p, item, ldsg, 32768); }
}


#define CTL_EUVQ 4400
__device__ __forceinline__ void euv_queue_work(const Params& p, volatile LAS unsigned* misc, int quota) {
    unsigned* ctr = (unsigned*)(p.ws + OFF_CTL) + CTL_EUVQ;
    for (int k = 0; k < quota; k += 8) {
        __syncthreads();
        if (opq_tid() == 0) misc[6] = __hip_atomic_fetch_add(ctr, 8u, __ATOMIC_RELAXED, __HIP_MEMORY_SCOPE_AGENT);
        __syncthreads();
        const int it0 = (int)misc[6];
        if (it0 >= 8192) break;
        for (int q = 0; q < 8; ++q) prep_euv_item(p, (it0 + q) >> 12, (it0 + q) & 4095);
    }
}
__device__ __forceinline__ void ph_merge_fast(const Params& p, int l, int nrows, LAS unsigned char* lds, int vb) {
    const bf16_t* Y = (const bf16_t*)(p.ws + OFF_Y); const unsigned char* G8 = p.ws + OFF_G8; bf16_t* M = (bf16_t*)(p.ws + OFF_M);
    const bf16_t* WB = (const bf16_t*)(p.ws + OFF_WBRT) + (size_t)l * WBRT_L;
    const int tidx = opq_tid(); const int lane = tidx & 63, wave = tidx >> 6, wr = wave >> 1, wc = wave & 1, fr = lane & 15, fq = lane >> 4;
    int m, n; bool have = tile_sched(0, vb, nrows / 128, 8, m, n); bool pre = false;
    for (int it = 0; have; ++it) {
        int mn, nn; const bool have_next = tile_sched(it + 1, vb, nrows / 128, 8, mn, nn);
        const int m0 = m * 128, n0 = n * 128;
        f32x4 macc[4][4];
#pragma unroll
        for (int mi = 0; mi < 4; ++mi)
#pragma unroll
            for (int ni = 0; ni < 4; ++ni) macc[mi][ni] = (f32x4){0.f, 0.f, 0.f, 0.f};
#pragma unroll 1
        for (int br = 0; br < 4; ++br) {
            const int K = br < 3 ? 256 : 512;
            f32x4 acc[4][4];
            const bf16_t* nA; const bf16_t* nB; int nK;
            if (br < 3) { nK = br < 2 ? 256 : 512; nA = Y + (size_t)m0 * YW + (br + 1) * 256; nB = WB + (size_t)(br + 1) * 1024 * 256 + (size_t)n0 * nK; }
            else { nK = 256; nA = have_next ? Y + (size_t)mn * 128 * YW : nullptr; nB = have_next ? WB + (size_t)nn * 128 * 256 : nullptr; }
            gemm_tile<true>(acc, Y + (size_t)m0 * YW + br * 256, YW, WB + (size_t)br * 1024 * 256 + (size_t)n0 * K, K, K, lds, pre, nA, YW, nB, nK);
            pre = (nA != nullptr);
#pragma unroll
            for (int mi = 0; mi < 4; ++mi) {
                const int row = m0 + wr * 64 + mi * 16 + fr;
                const u32x4 g4 = *(const u32x4*)(G8 + (size_t)row * 4096 + br * 1024 + n0 + wc * 64 + 16 * fq);
#pragma unroll
                for (int ni = 0; ni < 4; ++ni) {
                    const u32 g = g4[ni];
                    macc[mi][ni][0] += (float)(g & 255u) * acc[mi][ni][0]; macc[mi][ni][1] += (float)((g >> 8) & 255u) * acc[mi][ni][1];
                    macc[mi][ni][2] += (float)((g >> 16) & 255u) * acc[mi][ni][2]; macc[mi][ni][3] += (float)(g >> 24) * acc[mi][ni][3];
                }
                asm volatile("" ::: "memory");
            }
        }
#pragma unroll
        for (int mi = 0; mi < 4; ++mi) {
            const int row = m0 + wr * 64 + mi * 16 + fr;
            const uint2 s0 = pk4(macc[mi][0] * (1.f / 255.f)), s1 = pk4(macc[mi][1] * (1.f / 255.f)), s2 = pk4(macc[mi][2] * (1.f / 255.f)), s3 = pk4(macc[mi][3] * (1.f / 255.f));
            bf16_t* mo = M + (size_t)row * 1024 + n0 + wc * 64 + 16 * fq;
            *(uint4*)mo = make_uint4(s0.x, s0.y, s1.x, s1.y); *(uint4*)(mo + 8) = make_uint4(s2.x, s2.y, s3.x, s3.y);
        }
        have = have_next; m = mn; n = nn;
    }
}

__device__ __forceinline__ void ph_wout_fast(const Params& p, int l, int nrows, const float* xlat, const float* xctx, LAS unsigned char* lds, int vb) {
    const bf16_t* M = (const bf16_t*)(p.ws + OFF_M); bf16_t* Z = (bf16_t*)(p.ws + OFF_Z);
    const bf16_t* WT = (const bf16_t*)(p.ws + OFF_WOT) + (size_t)l * 1024 * 1024;
    const float* mods = (const float*)(p.ws + OFF_MODS) + (size_t)l * 5 * 6144;
    const int tidx = opq_tid(); const int lane = tidx & 63, wave = tidx >> 6, wr = wave >> 1, wc = wave & 1, fr = lane & 15, fq = lane >> 4;
    int m, n; bool have = tile_sched(0, vb, nrows / 128, 8, m, n); bool pre = false;
    for (int it = 0; have; ++it) {
        int mn, nn; const bool have_next = tile_sched(it + 1, vb, nrows / 128, 8, mn, nn);
        const int m0 = m * 128, n0 = n * 128;
        f32x4 acc[4][4];
        gemm_tile<true>(acc, M + (size_t)m0 * 1024, 1024, WT + (size_t)n0 * 1024, 1024, 1024, lds, pre,
                        have_next ? M + (size_t)mn * 128 * 1024 : nullptr, 1024, have_next ? WT + (size_t)nn * 128 * 1024 : nullptr, 1024);
        pre = have_next; have = have_next; m = mn; n = nn;
        const float* g1 = mods + (size_t)row_mod(m0) * 6144 + 2048;
#pragma unroll
        for (int mi = 0; mi < 4; ++mi) {
            const int row = m0 + wr * 64 + mi * 16 + fr;
            const float* xr = row < NLAT ? xlat + (size_t)row * 1024 : xctx + (size_t)(row - NLAT) * 1024;
            const int col = n0 + wc * 64 + 16 * fq;
            uint2 sz[4];
#pragma unroll
            for (int ni = 0; ni < 4; ++ni) {
                const f32x4 xv = *(const f32x4*)(xr + col + 4 * ni), gv = *(const f32x4*)(g1 + col + 4 * ni);
                sz[ni] = pk4(ALPHA * xv + gv * acc[mi][ni]);
            }
            *(uint4*)(Z + (size_t)row * 1024 + col) = make_uint4(sz[0].x, sz[0].y, sz[1].x, sz[1].y); *(uint4*)(Z + (size_t)row * 1024 + col + 8) = make_uint4(sz[2].x, sz[2].y, sz[3].x, sz[3].y);
        }
    }
}


__device__ __forceinline__ void attn_stage(LAS unsigned char* lds, int s, const bf16_t* Kp, int kstride, const bf16_t* Vp, int vstride, int wave, int lane) {
    const int sr = lane >> 3;
#pragma unroll
    for (int i = 0; i < 2; ++i) {
        const int j = 2 * wave + i; const int r = 8 * j + sr;
        const int ck = (lane & 7) ^ sr, cv = (lane & 7) ^ ((r >> 1) & 7);
        __builtin_amdgcn_global_load_lds((const unsigned*)(Kp + (size_t)r * kstride + ck * 8), (LAS unsigned*)(lds + s * 16384 + j * 1024), 16, 0, 0);
        __builtin_amdgcn_global_load_lds((const unsigned*)(Vp + (size_t)r * vstride + cv * 8), (LAS unsigned*)(lds + s * 16384 + 8192 + j * 1024), 16, 0, 0);
    }
}
template <int MODE>
__device__ __forceinline__ void attn_item(const Params& p, int l, int item, bool gqa, LAS unsigned char* lds) {
    const int tid = opq_tid(), lane = tid & 63, fr = lane & 15, fq = lane >> 4;
    const int wave = __builtin_amdgcn_readfirstlane(tid >> 6);
    const bf16_t* PL = (const bf16_t*)(p.ws + OFF_PL); bf16_t* Y = (bf16_t*)(p.ws + OFF_Y);
    int b, qrow0, qcol, kcol, ycol, vrow; float sink = 0.f; bool has_sink = false;
    int rstart = 0, rr = 0, t0 = 0, nch = 4, jlo = 0;
    if (MODE == 0) {
        if (!gqa) { const int qb = item & 3, h = (item >> 2) & 3; b = item >> 4; qrow0 = NLAT + b * 256 + qb * 64; qcol = PL_NQ + h * 64; kcol = PL_NK + h * 64; ycol = 256 + h * 64; vrow = b * 256 + h * 64; }
        else { const int qb = item & 3, hq = (item >> 2) & 7; b = item >> 5; qrow0 = NLAT + b * 256 + qb * 64; qcol = PL_GQ + hq * 64; kcol = PL_GK + (hq >> 2) * 64; ycol = 768 + hq * 64; vrow = b * 128 + (hq >> 2) * 64;
               sink = p.in[13][l * 8 + hq]; has_sink = true; }
    } else if (MODE == 1) {
        const int h = item & 3; rr = (item >> 2) & 63; b = item >> 8; qrow0 = b * 4096 + rr * 64; qcol = PL_NQ + h * 64; kcol = PL_NK + h * 64; ycol = 256 + h * 64; vrow = b * 256 + h * 64;
        rstart = min(max(rr - 4, 0), 56); nch = 12;
        const float* rp = p.in[12] + (size_t)(l * 4 + h) * 465; float* rs = (float*)((unsigned char*)lds + 65536);
        __syncthreads();
        for (int i = tid; i < 465; i += NTHREADS) rs[i] = rp[i] * 1.4426950409f;
    } else {
        const int hq = item & 7; const int tb = (item >> 3) & 63; b = item >> 9; t0 = tb * 64; qrow0 = b * 4096 + t0; qcol = PL_GQ + hq * 64; kcol = PL_GK + (hq >> 2) * 64; ycol = 768 + hq * 64; vrow = b * 128 + (hq >> 2) * 64;
        sink = p.in[13][l * 8 + hq]; has_sink = true;
        jlo = t0 == 0 ? 2 : (t0 == 64 ? 1 : 0); const int jhi = t0 == 4032 ? 2 : (t0 == 3968 ? 3 : 4);
        nch = 4 + (jhi - jlo + 1);
    }
    const bf16_t* VTC = (const bf16_t*)(p.ws + (gqa ? OFF_GVTC : OFF_NVTC)) + (size_t)vrow * 256;
    const bf16_t* VTL = (const bf16_t*)(p.ws + (gqa ? OFF_GVT : OFF_NVT)) + (size_t)vrow * 4096;
    const bf16_t* KC = PL + (size_t)(NLAT + b * 256) * PLW + kcol;
    const bf16_t* KL = PL + (size_t)(b * 4096) * PLW + kcol;
#define ATT_PTRS(c, Kp, Vp, vs) do { if ((c) < 4) { Kp = KC + (size_t)(c) * 64 * PLW; Vp = VTC + (c) * 64; vs = 256; } \
        else { const int key0_ = MODE == 1 ? (rstart + (c) - 4) * 64 : t0 - 128 + 64 * ((c) - 4 + jlo); Kp = KL + (size_t)key0_ * PLW; Vp = VTL + key0_; vs = 4096; } } while (0)
    const int qrow = qrow0 + 16 * wave + fr;
    const bf16_t* qp = PL + (size_t)qrow * PLW + qcol + 8 * fq;
    bf16x8 q0 = *(const bf16x8*)qp, q1 = *(const bf16x8*)(qp + 32);
    float m = -1e30f, lsum = 0.f;
    f32x4 o[4];
#pragma unroll
    for (int dt = 0; dt < 4; ++dt) o[dt] = (f32x4){0.f, 0.f, 0.f, 0.f};
    const int cq = 16 * wave + fr;
    const int cst = min(max(cq - 8, 0), 48);
    const int klo = min(max(16 * wave - 8, 0), 48) >> 4, khi = (min(max(16 * wave + 7, 0), 48) + 15) >> 4;
    asm volatile("" : "+v"(q0), "+v"(q1), "+v"(sink));
    __syncthreads();
#pragma unroll
    for (int c0 = 0; c0 < 3; ++c0) { const bf16_t* Kp; const bf16_t* Vp; int vs; ATT_PTRS(c0, Kp, Vp, vs); attn_stage(lds, c0, Kp, PLW, Vp, vs, wave, lane); }
    for (int c = 0; c < nch; ++c) {
        if (c + 2 < nch) asm volatile("s_waitcnt vmcnt(8)" ::: "memory");
        else if (c + 1 < nch) asm volatile("s_waitcnt vmcnt(4)" ::: "memory");
        else asm volatile("s_waitcnt vmcnt(0)" ::: "memory");
        asm volatile("s_waitcnt lgkmcnt(0)" ::: "memory");
        __builtin_amdgcn_s_barrier();
        asm volatile("" ::: "memory");
        if (c + 3 < nch) { const bf16_t* Kp; const bf16_t* Vp; int vs; ATT_PTRS(c + 3, Kp, Vp, vs); attn_stage(lds, (c + 3) & 3, Kp, PLW, Vp, vs, wave, lane); }
        const LAS unsigned char* Kb = lds + (c & 3) * 16384; const LAS unsigned char* Vb = Kb + 8192;
        const bool band = c >= 4;
        f32x4 sa[4]; bool on[4];
        float pm = -1e30f;
#pragma unroll
        for (int kt = 0; kt < 4; ++kt) {
            on[kt] = !(MODE == 1 && band) || (kt >= klo && kt <= khi);
            sa[kt] = (f32x4){0.f, 0.f, 0.f, 0.f};
            if (on[kt]) {
                const bf16x8 k0 = *(const LAS bf16x8*)(Kb + (16 * kt + fr) * 128 + (((0 + fq) ^ (fr & 7)) << 4));
                const bf16x8 k1 = *(const LAS bf16x8*)(Kb + (16 * kt + fr) * 128 + (((4 + fq) ^ (fr & 7)) << 4));
                sa[kt] = __builtin_amdgcn_mfma_f32_16x16x32_bf16(k0, q0, sa[kt], 0, 0, 0);
                sa[kt] = __builtin_amdgcn_mfma_f32_16x16x32_bf16(k1, q1, sa[kt], 0, 0, 0);
            }
        }
        if (MODE == 1 && band) {
            const float* rs = (const float*)((const unsigned char*)lds + 65536) + (rstart + (c - 4) - rr + 7) * 31 + (15 - cq);
#pragma unroll
            for (int kt = 0; kt < 4; ++kt) if (on[kt]) {
#pragma unroll
                for (int e = 0; e < 4; ++e) {
                    const int kk = 16 * kt + 4 * fq + e; const bool valid = (unsigned)(kk - cst) < 16u;
                    const float bias = rs[valid ? kk : cq];
                    const float sv = valid ? sa[kt][e] * 0.18033688f + bias : -1e30f;
                    sa[kt][e] = sv; pm = fmaxf(pm, sv);
                }
            }
        } else if (MODE == 2 && band && (c - 4 + jlo == 0 || c - 4 + jlo == 4)) {
            const int d0 = -128 + 64 * (c - 4 + jlo) - cq;
#pragma unroll
            for (int kt = 0; kt < 4; ++kt)
#pragma unroll
                for (int e = 0; e < 4; ++e) {
                    const int dlt = d0 + 16 * kt + 4 * fq + e; const bool valid = dlt >= -128 && dlt <= 128;
                    const float sv = valid ? sa[kt][e] * 0.18033688f : -1e30f;
                    sa[kt][e] = sv; pm = fmaxf(pm, sv);
                }
        } else {
#pragma unroll
            for (int kt = 0; kt < 4; ++kt)
#pragma unroll
                for (int e = 0; e < 4; ++e) { const float sv = sa[kt][e] * 0.18033688f; sa[kt][e] = sv; pm = fmaxf(pm, sv); }
        }
        pm = xmax32(xmax16(pm));
        const float mn = fmaxf(m, pm); const float alpha = __builtin_amdgcn_exp2f(m - mn); m = mn;
        float ps = 0.f;
#pragma unroll
        for (int kt = 0; kt < 4; ++kt) {
            if (on[kt]) {
#pragma unroll
                for (int e = 0; e < 4; ++e) { const float pv = __builtin_amdgcn_exp2f(sa[kt][e] - mn); sa[kt][e] = pv; ps += pv; }
            }
        }
        lsum = lsum * alpha + ps;
#pragma unroll
        for (int dt = 0; dt < 4; ++dt) o[dt] *= alpha;
#pragma unroll
        for (int s2 = 0; s2 < 2; ++s2) {
            if (!(on[2 * s2] || on[2 * s2 + 1])) continue;
            union { uint4 u; bf16x8 v; } pf;
            pf.u.x = pk2(sa[2 * s2][0], sa[2 * s2][1]); pf.u.y = pk2(sa[2 * s2][2], sa[2 * s2][3]);
            pf.u.z = pk2(sa[2 * s2 + 1][0], sa[2 * s2 + 1][1]); pf.u.w = pk2(sa[2 * s2 + 1][2], sa[2 * s2 + 1][3]);
            const int sw = (fr >> 1) & 7;
            const int a0 = (((4 * s2 + (fq >> 1)) ^ sw) << 4) + (fq & 1) * 8, a1 = (((4 * s2 + 2 + (fq >> 1)) ^ sw) << 4) + (fq & 1) * 8;
#pragma unroll
            for (int dt = 0; dt < 4; ++dt) {
                union { uint4 u; bf16x8 v; } vf;
                const u32x2 lo = *(const LAS u32x2*)(Vb + (16 * dt + fr) * 128 + a0), hi = *(const LAS u32x2*)(Vb + (16 * dt + fr) * 128 + a1);
                vf.u.x = lo[0]; vf.u.y = lo[1]; vf.u.z = hi[0]; vf.u.w = hi[1];
                o[dt] = __builtin_amdgcn_mfma_f32_16x16x32_bf16(vf.v, pf.v, o[dt], 0, 0, 0);
            }
        }
    }
#undef ATT_PTRS
    float lt = xsum32(xsum16(lsum));
    if (has_sink) lt += __builtin_amdgcn_exp2f(sink * 1.4426950409f - m);
    const float inv = 1.f / lt;
#pragma unroll
    for (int dt = 0; dt < 4; ++dt) o[dt] *= inv;
    {
        const uint2 s0 = pk4(o[0]), s1 = pk4(o[1]), s2 = pk4(o[2]), s3 = pk4(o[3]);
        bf16_t* yo = Y + (size_t)qrow * YW + ycol + 16 * fq;
        *(uint4*)yo = make_uint4(s0.x, s0.y, s1.x, s1.y); *(uint4*)(yo + 8) = make_uint4(s2.x, s2.y, s3.x, s3.y);
    }
}

__device__ __forceinline__ void attn_gqa4(const Params& p, int l, int item, LAS unsigned char* lds) {
    const int tid = opq_tid(), lane = tid & 63, fr = lane & 15, fq = lane >> 4;
    const int wave = __builtin_amdgcn_readfirstlane(tid >> 6);
    const bf16_t* PL = (const bf16_t*)(p.ws + OFF_PL); bf16_t* Y = (bf16_t*)(p.ws + OFF_Y);
    const int kvh = item & 1, tb = (item >> 1) & 63, b = item >> 7;
    const int t0 = tb * 64, qrow0 = b * 4096 + t0, kcol = PL_GK + kvh * 64, vrow = b * 128 + kvh * 64;
    const int jlo = t0 == 0 ? 2 : (t0 == 64 ? 1 : 0); const int jhi = t0 == 4032 ? 2 : (t0 == 3968 ? 3 : 4);
    const int nch = 4 + (jhi - jlo + 1);
    const bf16_t* VTC = (const bf16_t*)(p.ws + OFF_GVTC) + (size_t)vrow * 256;
    const bf16_t* VTL = (const bf16_t*)(p.ws + OFF_GVT) + (size_t)vrow * 4096;
    const bf16_t* KC = PL + (size_t)(NLAT + b * 256) * PLW + kcol;
    const bf16_t* KL = PL + (size_t)(b * 4096) * PLW + kcol;
#define ATT_PTRS(c, Kp, Vp, vs) do { if ((c) < 4) { Kp = KC + (size_t)(c) * 64 * PLW; Vp = VTC + (c) * 64; vs = 256; } \
        else { const int key0_ = t0 - 128 + 64 * ((c) - 4 + jlo); Kp = KL + (size_t)key0_ * PLW; Vp = VTL + key0_; vs = 4096; } } while (0)
    const int qrow = qrow0 + 16 * wave + fr;
    bf16x8 q0[4], q1[4]; float sink[4], m[4], lsum[4];
    f32x4 o[4][4];
#pragma unroll
    for (int hh = 0; hh < 4; ++hh) {
        const bf16_t* qp = PL + (size_t)qrow * PLW + PL_GQ + (kvh * 4 + hh) * 64 + 8 * fq;
        q0[hh] = *(const bf16x8*)qp; q1[hh] = *(const bf16x8*)(qp + 32);
        sink[hh] = p.in[13][l * 8 + kvh * 4 + hh]; m[hh] = -1e30f; lsum[hh] = 0.f;
#pragma unroll
        for (int dt = 0; dt < 4; ++dt) o[hh][dt] = (f32x4){0.f, 0.f, 0.f, 0.f};
    }
    const int cq = 16 * wave + fr;
#pragma unroll
    for (int hh = 0; hh < 4; ++hh) asm volatile("" : "+v"(q0[hh]), "+v"(q1[hh]), "+v"(sink[hh]));
    __syncthreads();
#pragma unroll
    for (int c0 = 0; c0 < 3; ++c0) { const bf16_t* Kp; const bf16_t* Vp; int vs; ATT_PTRS(c0, Kp, Vp, vs); attn_stage(lds, c0, Kp, PLW, Vp, vs, wave, lane); }
    for (int c = 0; c < nch; ++c) {
        if (c + 2 < nch) asm volatile("s_waitcnt vmcnt(8)" ::: "memory");
        else if (c + 1 < nch) asm volatile("s_waitcnt vmcnt(4)" ::: "memory");
        else asm volatile("s_waitcnt vmcnt(0)" ::: "memory");
        asm volatile("s_waitcnt lgkmcnt(0)" ::: "memory");
        __builtin_amdgcn_s_barrier();
        asm volatile("" ::: "memory");
        if (c + 3 < nch) { const bf16_t* Kp; const bf16_t* Vp; int vs; ATT_PTRS(c + 3, Kp, Vp, vs); attn_stage(lds, (c + 3) & 3, Kp, PLW, Vp, vs, wave, lane); }
        const LAS unsigned char* Kb = lds + (c & 3) * 16384; const LAS unsigned char* Vb = Kb + 8192;
        const bool edge = c >= 4 && (c - 4 + jlo == 0 || c - 4 + jlo == 4);
        const int d0 = -128 + 64 * (c - 4 + jlo) - cq;
#pragma unroll
        for (int hp = 0; hp < 2; ++hp) {
        uint4 pf[2][2];
        {
#pragma unroll
            for (int h2 = 0; h2 < 2; ++h2) { const int hh = 2 * hp + h2;
                f32x4 sa[4]; float pm = -1e30f;
#pragma unroll
                for (int kt = 0; kt < 4; ++kt) {
                    const bf16x8 k0 = *(const LAS bf16x8*)(Kb + (16 * kt + fr) * 128 + (((0 + fq) ^ (fr & 7)) << 4));
                    const bf16x8 k1 = *(const LAS bf16x8*)(Kb + (16 * kt + fr) * 128 + (((4 + fq) ^ (fr & 7)) << 4));
                    sa[kt] = __builtin_amdgcn_mfma_f32_16x16x32_bf16(k0, q0[hh], (f32x4){0.f, 0.f, 0.f, 0.f}, 0, 0, 0);
                    sa[kt] = __builtin_amdgcn_mfma_f32_16x16x32_bf16(k1, q1[hh], sa[kt], 0, 0, 0);
                }
                asm volatile("" ::: "memory");
                if (edge) {
#pragma unroll
                    for (int kt = 0; kt < 4; ++kt)
#pragma unroll
                        for (int e = 0; e < 4; ++e) {
                            const int dlt = d0 + 16 * kt + 4 * fq + e; const bool valid = dlt >= -128 && dlt <= 128;
                            const float sv = valid ? sa[kt][e] * 0.18033688f : -1e30f;
                            sa[kt][e] = sv; pm = fmaxf(pm, sv);
                        }
                } else {
#pragma unroll
                    for (int kt = 0; kt < 4; ++kt)
#pragma unroll
                        for (int e = 0; e < 4; ++e) { const float sv = sa[kt][e] * 0.18033688f; sa[kt][e] = sv; pm = fmaxf(pm, sv); }
                }
                pm = xmax32(xmax16(pm));
                const float mn = fmaxf(m[hh], pm); const float alpha = __builtin_amdgcn_exp2f(m[hh] - mn); m[hh] = mn;
                float ps = 0.f;
#pragma unroll
                for (int kt = 0; kt < 4; ++kt)
#pragma unroll
                    for (int e = 0; e < 4; ++e) { const float pv = __builtin_amdgcn_exp2f(sa[kt][e] - mn); sa[kt][e] = pv; ps += pv; }
                lsum[hh] = lsum[hh] * alpha + ps;
#pragma unroll
                for (int dt = 0; dt < 4; ++dt) o[hh][dt] *= alpha;
#pragma unroll
                for (int s2 = 0; s2 < 2; ++s2)
                    pf[h2][s2] = make_uint4(pk2(sa[2 * s2][0], sa[2 * s2][1]), pk2(sa[2 * s2][2], sa[2 * s2][3]), pk2(sa[2 * s2 + 1][0], sa[2 * s2 + 1][1]), pk2(sa[2 * s2 + 1][2], sa[2 * s2 + 1][3]));
            }
        }
#pragma unroll
        for (int s2 = 0; s2 < 2; ++s2) {
            const int sw = (fr >> 1) & 7;
            const int a0 = (((4 * s2 + (fq >> 1)) ^ sw) << 4) + (fq & 1) * 8, a1 = (((4 * s2 + 2 + (fq >> 1)) ^ sw) << 4) + (fq & 1) * 8;
#pragma unroll
            for (int dt = 0; dt < 4; ++dt) {
                union { uint4 u; bf16x8 v; } vf;
                const u32x2 lo = *(const LAS u32x2*)(Vb + (16 * dt + fr) * 128 + a0), hi = *(const LAS u32x2*)(Vb + (16 * dt + fr) * 128 + a1);
                vf.u.x = lo[0]; vf.u.y = lo[1]; vf.u.z = hi[0]; vf.u.w = hi[1];
#pragma unroll
                for (int h2 = 0; h2 < 2; ++h2) { union { uint4 u; bf16x8 v; } pq; pq.u = pf[h2][s2]; o[2 * hp + h2][dt] = __builtin_amdgcn_mfma_f32_16x16x32_bf16(vf.v, pq.v, o[2 * hp + h2][dt], 0, 0, 0); }
            }
        }
        asm volatile("" ::: "memory");
        }
    }
#undef ATT_PTRS
#pragma unroll
    for (int hh = 0; hh < 4; ++hh) {
        float lt = xsum32(xsum16(lsum[hh]));
        lt += __builtin_amdgcn_exp2f(sink[hh] * 1.4426950409f - m[hh]);
        const float inv = 1.f / lt;
#pragma unroll
        for (int dt = 0; dt < 4; ++dt) o[hh][dt] *= inv;
        const uint2 s0 = pk4(o[hh][0]), s1 = pk4(o[hh][1]), s2 = pk4(o[hh][2]), s3 = pk4(o[hh][3]);
        bf16_t* yo = Y + (size_t)qrow * YW + 768 + (kvh * 4 + hh) * 64 + 16 * fq;
        *(uint4*)yo = make_uint4(s0.x, s0.y, s1.x, s1.y); *(uint4*)(yo + 8) = make_uint4(s2.x, s2.y, s3.x, s3.y);
    }
}

__device__ __forceinline__ void attn_nat2(const Params& p, int l, int item, LAS unsigned char* lds) {
    const int tid = opq_tid(), lane = tid & 63, fr = lane & 15, fq = lane >> 4;
    const int wave = __builtin_amdgcn_readfirstlane(tid >> 6);
    const bf16_t* PL = (const bf16_t*)(p.ws + OFF_PL); bf16_t* Y = (bf16_t*)(p.ws + OFF_Y);
    const int h = item & 3, jp = (item >> 2) & 31, b = item >> 7;
    const int rrA = 2 * jp, rsA = min(max(rrA - 4, 0), 56), rsB = min(max(rrA - 3, 0), 56);
    const int nch = 4 + (rsB + 8 - rsA);
    const int qcol = PL_NQ + h * 64, kcol = PL_NK + h * 64, vrow = b * 256 + h * 64;
    {
        const float* rp = p.in[12] + (size_t)(l * 4 + h) * 465; float* rs = (float*)((unsigned char*)lds + 65536);
        __syncthreads();
        for (int i = tid; i < 465; i += NTHREADS) rs[i] = rp[i] * 1.4426950409f;
    }
    const bf16_t* VTC = (const bf16_t*)(p.ws + OFF_NVTC) + (size_t)vrow * 256;
    const bf16_t* VTL = (const bf16_t*)(p.ws + OFF_NVT) + (size_t)vrow * 4096;
    const bf16_t* KC = PL + (size_t)(NLAT + b * 256) * PLW + kcol;
    const bf16_t* KL = PL + (size_t)(b * 4096) * PLW + kcol;
#define ATT_PTRS(c, Kp, Vp, vs) do { if ((c) < 4) { Kp = KC + (size_t)(c) * 64 * PLW; Vp = VTC + (c) * 64; vs = 256; } \
        else { const int key0_ = (rsA + (c) - 4) * 64; Kp = KL + (size_t)key0_ * PLW; Vp = VTL + key0_; vs = 4096; } } while (0)
    const int cq = 16 * wave + fr;
    bf16x8 q0[2], q1[2]; float m[2], lsum[2];
    f32x4 o[2][4];
#pragma unroll
    for (int g = 0; g < 2; ++g) {
        const bf16_t* qp = PL + (size_t)(b * 4096 + (rrA + g) * 64 + cq) * PLW + qcol + 8 * fq;
        q0[g] = *(const bf16x8*)qp; q1[g] = *(const bf16x8*)(qp + 32); m[g] = -1e30f; lsum[g] = 0.f;
#pragma unroll
        for (int dt = 0; dt < 4; ++dt) o[g][dt] = (f32x4){0.f, 0.f, 0.f, 0.f};
    }
    const int cst = min(max(cq - 8, 0), 48);
    const int klo = min(max(16 * wave - 8, 0), 48) >> 4, khi = (min(max(16 * wave + 7, 0), 48) + 15) >> 4;
#pragma unroll
    for (int g = 0; g < 2; ++g) asm volatile("" : "+v"(q0[g]), "+v"(q1[g]));
    __syncthreads();
#pragma unroll
    for (int c0 = 0; c0 < 3; ++c0) { const bf16_t* Kp; const bf16_t* Vp; int vs; ATT_PTRS(c0, Kp, Vp, vs); attn_stage(lds, c0, Kp, PLW, Vp, vs, wave, lane); }
    for (int c = 0; c < nch; ++c) {
        if (c + 2 < nch) asm volatile("s_waitcnt vmcnt(8)" ::: "memory");
        else if (c + 1 < nch) asm volatile("s_waitcnt vmcnt(4)" ::: "memory");
        else asm volatile("s_waitcnt vmcnt(0)" ::: "memory");
        asm volatile("s_waitcnt lgkmcnt(0)" ::: "memory");
        __builtin_amdgcn_s_barrier();
        asm volatile("" ::: "memory");
        if (c + 3 < nch) { const bf16_t* Kp; const bf16_t* Vp; int vs; ATT_PTRS(c + 3, Kp, Vp, vs); attn_stage(lds, (c + 3) & 3, Kp, PLW, Vp, vs, wave, lane); }
        const LAS unsigned char* Kb = lds + (c & 3) * 16384; const LAS unsigned char* Vb = Kb + 8192;
        const bool band = c >= 4;
        const int kr = rsA + c - 4;
        bool on[4];
#pragma unroll
        for (int kt = 0; kt < 4; ++kt) on[kt] = !band || (kt >= klo && kt <= khi);
        bf16x8 k0[4], k1[4];
#pragma unroll
        for (int kt = 0; kt < 4; ++kt) if (on[kt]) {
            k0[kt] = *(const LAS bf16x8*)(Kb + (16 * kt + fr) * 128 + (((0 + fq) ^ (fr & 7)) << 4));
            k1[kt] = *(const LAS bf16x8*)(Kb + (16 * kt + fr) * 128 + (((4 + fq) ^ (fr & 7)) << 4));
        }
        uint4 pf[2][2]; bool act[2];
#pragma unroll
        for (int g = 0; g < 2; ++g) {
            act[g] = !band || (g == 0 ? kr <= rsA + 7 : kr >= rsB);
            if (!act[g]) continue;
            f32x4 sa[4]; float pm = -1e30f;
#pragma unroll
            for (int kt = 0; kt < 4; ++kt) {
                sa[kt] = (f32x4){0.f, 0.f, 0.f, 0.f};
                if (on[kt]) {
                    sa[kt] = __builtin_amdgcn_mfma_f32_16x16x32_bf16(k0[kt], q0[g], sa[kt], 0, 0, 0);
                    sa[kt] = __builtin_amdgcn_mfma_f32_16x16x32_bf16(k1[kt], q1[g], sa[kt], 0, 0, 0);
                }
            }
            if (band) {
                const float* rs = (const float*)((const unsigned char*)lds + 65536) + (kr - (rrA + g) + 7) * 31 + (15 - cq);
#pragma unroll
                for (int kt = 0; kt < 4; ++kt) if (on[kt]) {
#pragma unroll
                    for (int e = 0; e < 4; ++e) {
                        const int kk = 16 * kt + 4 * fq + e; const bool valid = (unsigned)(kk - cst) < 16u;
                        const float bias = rs[valid ? kk : cq];
                        const float sv = valid ? sa[kt][e] * 0.18033688f + bias : -1e30f;
                        sa[kt][e] = sv; pm = fmaxf(pm, sv);
                    }
                }
            } else {
#pragma unroll
                for (int kt = 0; kt < 4; ++kt)
#pragma unroll
                    for (int e = 0; e < 4; ++e) { const float sv = sa[kt][e] * 0.18033688f; sa[kt][e] = sv; pm = fmaxf(pm, sv); }
            }
            pm = xmax32(xmax16(pm));
            const float mn = fmaxf(m[g], pm); const float alpha = __builtin_amdgcn_exp2f(m[g] - mn); m[g] = mn;
            float ps = 0.f;
#pragma unroll
            for (int kt = 0; kt < 4; ++kt) {
                if (on[kt]) {
#pragma unroll
                    for (int e = 0; e < 4; ++e) { const float pv = __builtin_amdgcn_exp2f(sa[kt][e] - mn); sa[kt][e] = pv; ps += pv; }
                }
            }
            lsum[g] = lsum[g] * alpha + ps;
#pragma unroll
            for (int dt = 0; dt < 4; ++dt) o[g][dt] *= alpha;
#pragma unroll
            for (int s2 = 0; s2 < 2; ++s2)
                pf[g][s2] = make_uint4(pk2(sa[2 * s2][0], sa[2 * s2][1]), pk2(sa[2 * s2][2], sa[2 * s2][3]), pk2(sa[2 * s2 + 1][0], sa[2 * s2 + 1][1]), pk2(sa[2 * s2 + 1][2], sa[2 * s2 + 1][3]));
        }
#pragma unroll
        for (int s2 = 0; s2 < 2; ++s2) {
            if (!(on[2 * s2] || on[2 * s2 + 1])) continue;
            const int sw = (fr >> 1) & 7;
            const int a0 = (((4 * s2 + (fq >> 1)) ^ sw) << 4) + (fq & 1) * 8, a1 = (((4 * s2 + 2 + (fq >> 1)) ^ sw) << 4) + (fq & 1) * 8;
#pragma unroll
            for (int dt = 0; dt < 4; ++dt) {
                union { uint4 u; bf16x8 v; } vf;
                const u32x2 lo = *(const LAS u32x2*)(Vb + (16 * dt + fr) * 128 + a0), hi = *(const LAS u32x2*)(Vb + (16 * dt + fr) * 128 + a1);
                vf.u.x = lo[0]; vf.u.y = lo[1]; vf.u.z = hi[0]; vf.u.w = hi[1];
#pragma unroll
                for (int g = 0; g < 2; ++g) if (act[g]) { union { uint4 u; bf16x8 v; } pq; pq.u = pf[g][s2]; o[g][dt] = __builtin_amdgcn_mfma_f32_16x16x32_bf16(vf.v, pq.v, o[g][dt], 0, 0, 0); }
            }
        }
    }
#undef ATT_PTRS
#pragma unroll
    for (int g = 0; g < 2; ++g) {
        const float lt = xsum32(xsum16(lsum[g]));
        const float inv = 1.f / lt;
#pragma unroll
        for (int dt = 0; dt < 4; ++dt) o[g][dt] *= inv;
        const uint2 s0 = pk4(o[g][0]), s1 = pk4(o[g][1]), s2 = pk4(o[g][2]), s3 = pk4(o[g][3]);
        bf16_t* yo = Y + (size_t)(b * 4096 + (rrA + g) * 64 + cq) * YW + 256 + h * 64 + 16 * fq;
        *(uint4*)yo = make_uint4(s0.x, s0.y, s1.x, s1.y); *(uint4*)(yo + 8) = make_uint4(s2.x, s2.y, s3.x, s3.y);
    }
}

__device__ __forceinline__ void conv_tile(const Params& p, int l, int tile, unsigned char* ldsg) {
    const int tid = opq_tid(), lane = tid & 63, wave = tid >> 6;
    bf16_t* hb = (bf16_t*)ldsg;
    float* ob = (float*)(ldsg + 32768);
    const bf16_t* PL = (const bf16_t*)(p.ws + OFF_PL); bf16_t* Y = (bf16_t*)(p.ws + OFF_Y);
    const int row0 = tile * 32; const bool lat = row0 < NLAT;
    const int t0 = lat ? (row0 & 4095) : ((row0 - NLAT) & 255); const int T = lat ? 4096 : 256; const int seqbase = row0 - t0;
    uint4 av[8], gv[8];
#pragma unroll
    for (int q = 0; q < 8; ++q) {
        const int idx = tid + NTHREADS * q; const int r = idx >> 5, cch = idx & 31; const int tt = min(max(t0 - 15 + r, 0), T - 1);
        const bf16_t* src = PL + (size_t)(seqbase + tt) * PLW + cch * 8;
        av[q] = *(const uint4*)src; gv[q] = *(const uint4*)(src + 256);
    }
    float w[31];
    const float* cw = p.in[8] + (size_t)l * 31 * 256 + tid;
#pragma unroll
    for (int k = 0; k < 31; ++k) w[k] = cw[k * 256];
    const float cb = p.in[9][l * 256 + tid];
    __syncthreads();
#pragma unroll
    for (int q = 0; q < 8; ++q) {
        const int idx = tid + NTHREADS * q; const int r = idx >> 5, cch = idx & 31; const int tt = t0 - 15 + r;
        if (idx < 62 * 32) {
            const u32 a4[4] = {av[q].x, av[q].y, av[q].z, av[q].w}, g4[4] = {gv[q].x, gv[q].y, gv[q].z, gv[q].w}; u32 ov[4];
#pragma unroll
            for (int e = 0; e < 4; ++e) {
                const float h0 = __uint_as_float(a4[e] << 16) * sigmoid_f(__uint_as_float(g4[e] << 16));
                const float h1 = __uint_as_float(a4[e] & 0xffff0000u) * sigmoid_f(__uint_as_float(g4[e] & 0xffff0000u));
                ov[e] = pk2(h0, h1);
            }
            const bool ok = tt >= 0 && tt < T;
            *(uint4*)(hb + r * 256 + cch * 8) = ok ? make_uint4(ov[0], ov[1], ov[2], ov[3]) : make_uint4(0u, 0u, 0u, 0u);
        }
    }
    __syncthreads();
    {
        float hv[62];
#pragma unroll
        for (int i = 0; i < 62; ++i) hv[i] = bf2f(hb[i * 256 + tid]);
#pragma unroll
        for (int t = 0; t < 32; ++t) {
            float acc = cb;
#pragma unroll
            for (int k = 0; k < 31; ++k) acc += hv[t + k] * w[k];
            ob[t * 256 + tid] = acc;
        }
    }
    __syncthreads();
    const f32x4 lg = *(const f32x4*)(p.in[10] + l * 256 + lane * 4), lb = *(const f32x4*)(p.in[11] + l * 256 + lane * 4);
    f32x4 v[8]; float sm[8];
#pragma unroll
    for (int i = 0; i < 8; ++i) { v[i] = *(const f32x4*)(ob + (wave * 8 + i) * 256 + lane * 4); sm[i] = (v[i][0] + v[i][1]) + (v[i][2] + v[i][3]); }
#pragma unroll
    for (int i = 0; i < 8; ++i) sm[i] = wave_sum(sm[i]);
#pragma unroll
    for (int i = 0; i < 8; ++i) { v[i] = v[i] - sm[i] * (1.f / 256.f); sm[i] = (v[i][0] * v[i][0] + v[i][1] * v[i][1]) + (v[i][2] * v[i][2] + v[i][3] * v[i][3]); }
#pragma unroll
    for (int i = 0; i < 8; ++i) sm[i] = wave_sum(sm[i]);
#pragma unroll
    for (int i = 0; i < 8; ++i) {
        f32x4 y = v[i] * rsqrtf(sm[i] * (1.f / 256.f) + LN_EPS) * lg + lb;
#pragma unroll
        for (int e = 0; e < 4; ++e) y[e] = y[e] * sigmoid_f(y[e]);
        *(uint2*)(Y + (size_t)(row0 + wave * 8 + i) * YW + lane * 4) = pk4(y);
    }
}

__device__ __forceinline__ void dft_tile(const Params& p, int idx, LAS unsigned char* lds) {
    bf16_t* Y = (bf16_t*)(p.ws + OFF_Y);
    const int tidx = opq_tid(); const int lane = tidx & 63, wave = tidx >> 6, wr = wave >> 1, wc = wave & 1, fr = lane & 15, fq = lane >> 4;
    f32x4 acc[4][4];
    const int t = idx - 256; const int n = t & 1, m = (t >> 1) & 1, b = t >> 2;
    gemm_tile<true>(acc, (const bf16_t*)(p.ws + OFF_TWC) + (size_t)m * 128 * 512, 512, (const bf16_t*)(p.ws + OFF_HTC) + ((size_t)b * 256 + n * 128) * 512, 512, 512, lds);
    const int row0 = NLAT + b * 256 + m * 128;
#pragma unroll
    for (int mi = 0; mi < 4; ++mi) {
        const int row = row0 + wr * 64 + mi * 16 + fr;
#pragma unroll
        for (int ni = 0; ni < 4; ++ni) *(uint2*)(Y + (size_t)row * YW + 512 + n * 128 + wc * 64 + ni * 16 + 4 * fq) = pk4(acc[mi][ni]);
    }
}


__device__ __forceinline__ void fft_item(const Params& p, int item, unsigned char* ldsg, bf16_t* Yout, int ldy, int ycol0) {
    LAS unsigned char* lds = (LAS unsigned char*)ldsg;
    const float* tabh = (const float*)(ldsg + PREP_TAB_OFF);
    const int tid = opq_tid(), lane = tid & 63, fr = lane & 15, fq = lane >> 4;
    const int wave = __builtin_amdgcn_readfirstlane(tid >> 6);
    const int grp = (item & 7) * 8 + (item >> 6), dg = (item >> 3) & 7; const int b = grp >> 4, cg = grp & 15;
    bf16x8 f1[4];
    {
        const bf16_t* B1 = (const bf16_t*)(p.ws + OFF_FB1) + (size_t)(16 * dg + fr) * 128 + 8 * fq;
#pragma unroll
        for (int ks = 0; ks < 4; ++ks) f1[ks] = *(const bf16x8*)(B1 + 32 * ks);
    }
    __syncthreads();
#pragma unroll 1
    for (int jj = 0; jj < 4; ++jj) {
        const int j = 4 * wave + jj;
        const bf16_t* H = (const bf16_t*)(p.ws + OFF_HT2) + (((size_t)b * 256 + 16 * cg + j) * 64 + fr) * 128 + 8 * fq;
        bf16x8 h[4][4];
#pragma unroll
        for (int mt = 0; mt < 4; ++mt)
#pragma unroll
            for (int ks = 0; ks < 4; ++ks) h[mt][ks] = *(const bf16x8*)(H + (size_t)mt * 16 * 128 + 32 * ks);
        f32x4 acc[4];
#pragma unroll
        for (int mt = 0; mt < 4; ++mt) {
            acc[mt] = (f32x4){0.f, 0.f, 0.f, 0.f};
#pragma unroll
            for (int ks = 0; ks < 4; ++ks) acc[mt] = __builtin_amdgcn_mfma_f32_16x16x32_bf16(f1[ks], h[mt][ks], acc[mt], 0, 0, 0);
        }
#pragma unroll
        for (int mt = 0; mt < 4; ++mt) {
            const int a = 16 * mt + fr;
#pragma unroll
            for (int h2 = 0; h2 < 2; ++h2) {
                const int dl = 2 * fq + h2, d = 8 * dg + dl;
                const float re = acc[mt][2 * h2], im = acc[mt][2 * h2 + 1];
                const int m = a * d;
                const float cs = tab_cos(tabh, m), sn = tab_cos(tabh, m + 3072);
                const float re2 = re * cs + im * sn, im2 = im * cs - re * sn;
                const int row = 16 * dl + j;
                const int o0 = row * 256 + ((((a >> 3)) ^ (row & 15)) << 4) + (a & 7) * 2, o1 = row * 256 + (((8 + (a >> 3)) ^ (row & 15)) << 4) + (a & 7) * 2;
                *(LAS bf16_t*)(lds + o0) = f2bf(re2);
                *(LAS bf16_t*)(lds + o1) = f2bf(im2);
            }
        }
    }
    bf16x8 f3[4][4];
    {
        const bf16_t* B3 = (const bf16_t*)(p.ws + OFF_FB3) + (size_t)fr * 128 + 8 * fq;
#pragma unroll
        for (int ct = 0; ct < 4; ++ct)
#pragma unroll
            for (int ks = 0; ks < 4; ++ks) f3[ct][ks] = *(const bf16x8*)(B3 + (size_t)ct * 16 * 128 + 32 * ks);
    }
    __syncthreads();
#pragma unroll
    for (int dd = 0; dd < 2; ++dd) {
        const int dl = 2 * wave + dd; const int row = 16 * dl + fr;
        bf16x8 g[4];
#pragma unroll
        for (int ks = 0; ks < 4; ++ks) g[ks] = *(const LAS bf16x8*)(lds + row * 256 + (((4 * ks + fq) ^ (row & 15)) << 4));
#pragma unroll
        for (int ct = 0; ct < 4; ++ct) {
            f32x4 o = (f32x4){0.f, 0.f, 0.f, 0.f};
#pragma unroll
            for (int ks = 0; ks < 4; ++ks) o = __builtin_amdgcn_mfma_f32_16x16x32_bf16(g[ks], f3[ct][ks], o, 0, 0, 0);
            const int k = 64 * (16 * ct + fr) + 8 * dg + dl;
            *(uint2*)(Yout + (size_t)(b * 4096 + k) * ldy + ycol0 + 16 * cg + 4 * fq) = pk4(o);
        }
    }
}

__device__ __forceinline__ void ph_mixers_fast(const Params& p, int l, unsigned char* ldsg) {
    LAS unsigned char* lds = (LAS unsigned char*)ldsg;
    const bool ctx = (l == 0);
    const int nG = 2048, nN = 1024, nC = 512, nGc = ctx ? 128 : 0, nNc = ctx ? 64 : 0, nCc = ctx ? 32 : 0, nDc = ctx ? 16 : 0;
    const int vbx = blockIdx.x, G = gridDim.x;
    (void)nG; (void)nN;
    const int rot = vbx >= (G >> 1) ? 2 : 0;
#pragma unroll 1
    for (int st = 0; st < 4; ++st) {
        const int k = (st + rot) & 3;
        if (k == 0) {
            prep_tables(ldsg);
            for (int it = vbx; it < 512; it += G) fft_item(p, it, ldsg, (bf16_t*)(p.ws + OFF_Y), YW, 512);
        } else if (k == 1) { for (int it = vbx; it < 512; it += G) attn_gqa4(p, l, it, lds); }
        else if (k == 2) { for (int it = vbx; it < 512; it += G) attn_nat2(p, l, it, lds); }
        else { for (int it = vbx; it < nC; it += G) conv_tile(p, l, it, ldsg); }
    }
    if (ctx) {
        for (int it = vbx; it < nGc + nNc + nCc + nDc; it += G) {
            if (it < nGc) attn_item<0>(p, l, it, true, lds);
            else if (it < nGc + nNc) attn_item<0>(p, l, it - nGc, false, lds);
            else if (it < nGc + nNc + nCc) conv_tile(p, l, 512 + it - nGc - nNc, ldsg);
            else dft_tile(p, 256 + it - nGc - nNc - nCc, lds);
        }
    }
}


template <int BITS>
__device__ __forceinline__ void exp_load(const unsigned char* rowp, unsigned off2, u32 (&w)[EXPERT_BITS]) {
    const uint4 a = *(const uint4*)rowp;
    w[0] = a.x; w[1] = a.y; w[2] = a.z; w[3] = a.w;
    if (BITS == 6) { const uint2 c = *(const uint2*)(rowp + off2); w[4] = c.x; w[5] = c.y; } else { w[4] = 0u; w[5] = 0u; }
}
template <int BITS>
__device__ __forceinline__ void exp_decode(const u32 (&w)[EXPERT_BITS], f32x2 (&o)[16]) {
    if (BITS == 6) {
        u32x6v v; v[0] = w[0]; v[1] = w[1]; v[2] = w[2]; v[3] = w[3]; v[4] = w[4]; v[5] = w[5];
        const f32x32v r = __builtin_amdgcn_cvt_scalef32_pk32_f32_fp6(v, 1.0f);
#pragma unroll
        for (int k = 0; k < 16; ++k) o[k] = (f32x2){r[2 * k], r[2 * k + 1]};
    } else {
#pragma unroll
        for (int q = 0; q < 4; ++q) {
            o[4 * q + 0] = __builtin_amdgcn_cvt_scalef32_pk_f32_fp4(w[q], 1.0f, 0); o[4 * q + 1] = __builtin_amdgcn_cvt_scalef32_pk_f32_fp4(w[q], 1.0f, 1);
            o[4 * q + 2] = __builtin_amdgcn_cvt_scalef32_pk_f32_fp4(w[q], 1.0f, 2); o[4 * q + 3] = __builtin_amdgcn_cvt_scalef32_pk_f32_fp4(w[q], 1.0f, 3);
        }
    }
}
__device__ __forceinline__ void ph_expert_sub(const Params& p, int l, int nrows, float* outlat, float* outctx, bool fuse_next, int vb, int nblk) {
    const int tidx = opq_tid(); const int wave = tidx >> 6, lane = tidx & 63;
    const float* mods = (const float*)(p.ws + OFF_MODS) + (size_t)l * 5 * 6144;
    const bf16_t* Zb = (const bf16_t*)(p.ws + OFF_Z); const bf16_t* U = (const bf16_t*)(p.ws + OFF_U);
    const float* l1g = p.in[19] + l * 1024; const float* l1b = p.in[20] + l * 1024;
    const int* EIDX = (const int*)(p.ws + OFF_EIDX); const float* GATE = (const float*)(p.ws + OFF_GATE);
    const unsigned char* EU = p.ws + OFF_EUV + (size_t)(l * 2) * 16384 * EXP_ROWB; const unsigned char* EV = EU + (size_t)16384 * EXP_ROWB;
    bf16_t* XLN = (bf16_t*)(p.ws + OFF_XLN);
    const float* lg = p.in[26] + l * 1024; const float* lb = p.in[27] + l * 1024;
    const int hf = lane >> 5, j = lane & 31, b4 = (lane >> 4) & 1, b3 = (lane >> 3) & 1;
    const int eL = 4 * b4 + 2 * b3 + hf;
    const unsigned laneoff = (unsigned)j * 16u, off2 = 512u - (unsigned)j * 8u;
    for (int r = vb * 4 + wave; r < nrows; r += nblk * 4) {
        f32x2 u[16];
        {
            const bf16_t* up = U + (size_t)r * 1024 + j * 32;
#pragma unroll
            for (int q = 0; q < 4; ++q) {
                const uint4 t = *(const uint4*)(up + 8 * q); const u32 tw[4] = {t.x, t.y, t.z, t.w};
#pragma unroll
                for (int k = 0; k < 4; ++k) u[4 * q + k] = (f32x2){__uint_as_float(tw[k] << 16), __uint_as_float(tw[k] & 0xffff0000u)};
            }
        }
        const int ei0 = EIDX[(size_t)r * 128 + lane], ei1 = EIDX[(size_t)r * 128 + 64 + lane];
        const float gt0 = GATE[(size_t)r * 128 + lane], gt1 = GATE[(size_t)r * 128 + 64 + lane];
        f32x2 acc2[16];
#pragma unroll
        for (int i = 0; i < 16; ++i) acc2[i] = (f32x2){0.f, 0.f};
#pragma unroll 1
        for (int bt = 0; bt < 16; ++bt) {
            const int eib = bt < 8 ? ei0 : ei1; const float gtb = bt < 8 ? gt0 : gt1; const int kb = (bt & 7) * 8;
            unsigned re[4];
#pragma unroll
            for (int q = 0; q < 4; ++q) { const int ea = __builtin_amdgcn_readlane(eib, kb + 2 * q), eb = __builtin_amdgcn_readlane(eib, kb + 2 * q + 1); re[q] = (unsigned)(hf ? eb : ea); }
            u32 wu[4][EXPERT_BITS], wv[4][EXPERT_BITS];
#pragma unroll
            for (int q = 0; q < 4; ++q) exp_load<EU_BITS>(EU + (size_t)re[q] * (EU_BITS * 128) + laneoff, off2, wu[q]);
#pragma unroll
            for (int q = 0; q < 4; ++q) exp_load<EV_BITS>(EV + (size_t)re[q] * (EV_BITS * 128) + laneoff, off2, wv[q]);
            float d[4];
#pragma unroll
            for (int q = 0; q < 4; ++q) {
                f32x2 w[16]; exp_decode<EU_BITS>(wu[q], w);
                f32x2 dd = w[0] * u[0];
#pragma unroll
                for (int k = 1; k < 16; ++k) dd = __builtin_elementwise_fma(w[k], u[k], dd);
                d[q] = dd[0] + dd[1];
            }
            float r1[2], r3;
#pragma unroll
            for (int i = 0; i < 2; ++i) { float a = d[i], b = d[i + 2]; swap16(a, b); r1[i] = a + b; }
            { const float snd = b3 ? r1[0] : r1[1], keep = b3 ? r1[1] : r1[0]; r3 = keep + dpp_f<DPP_ROR8>(snd); }
            r3 = sum8(r3);
            const float g = __builtin_bit_cast(float, __builtin_amdgcn_ds_bpermute((kb + eL) << 2, __builtin_bit_cast(int, gtb)));
            const float coef = g * gelu_erf(r3 * (1.f / EU_SCALE)) * (1.f / EV_SCALE);
#pragma unroll
            for (int q = 0; q < 4; ++q) {
                const int src = ((q >> 1) & 1) * 16 + (q & 1) * 8;
                const float c0 = __builtin_bit_cast(float, __builtin_amdgcn_readlane(__builtin_bit_cast(int, coef), src));
                const float c1 = __builtin_bit_cast(float, __builtin_amdgcn_readlane(__builtin_bit_cast(int, coef), src + 32));
                const float c = hf ? c1 : c0;
                f32x2 w[16]; exp_decode<EV_BITS>(wv[q], w);
                const f32x2 cc = (f32x2){c, c};
#pragma unroll
                for (int k = 0; k < 16; ++k) acc2[k] = __builtin_elementwise_fma(w[k], cc, acc2[k]);
            }
        }
        float acc[16];
#pragma unroll
        for (int k = 0; k < 8; ++k) {
            { float a = acc2[k][0], b = acc2[8 + k][0]; swap32(a, b); acc[2 * k] = a + b; }
            { float a = acc2[k][1], b = acc2[8 + k][1]; swap32(a, b); acc[2 * k + 1] = a + b; }
        }
        const int ebase = 32 * j + 16 * hf;
        const int mi = row_mod(r);
        const float* g2 = mods + (size_t)mi * 6144 + 5120;
        f32x4 zv[4]; float sz = 0.f;
#pragma unroll
        for (int h = 0; h < 4; ++h) { const uint2 t = *(const uint2*)(Zb + (size_t)r * 1024 + ebase + 4 * h);
            zv[h] = (f32x4){__uint_as_float(t.x << 16), __uint_as_float(t.x & 0xffff0000u), __uint_as_float(t.y << 16), __uint_as_float(t.y & 0xffff0000u)}; sz += (zv[h][0] + zv[h][1]) + (zv[h][2] + zv[h][3]); }
        const float mz = wave_sum(sz) * (1.f / 1024.f); float qz = 0.f;
#pragma unroll
        for (int h = 0; h < 4; ++h) { zv[h] = zv[h] - mz; qz += (zv[h][0] * zv[h][0] + zv[h][1] * zv[h][1]) + (zv[h][2] * zv[h][2] + zv[h][3] * zv[h][3]); }
        const float rz = rsqrtf(wave_sum(qz) * (1.f / 1024.f) + LN_EPS);
        float s = 0.f;
#pragma unroll
        for (int h = 0; h < 4; ++h) {
            const int i0 = ebase + 4 * h;
            const f32x4 x = zv[h] * rz * *(const f32x4*)(l1g + i0) + *(const f32x4*)(l1b + i0), gg = *(const f32x4*)(g2 + i0);
#pragma unroll
            for (int q = 0; q < 4; ++q) { const float v = ALPHA * x[q] + gg[q] * acc[4 * h + q]; acc[4 * h + q] = v; s += v; }
        }
        const float mean = wave_sum(s) * (1.f / 1024.f); float q2 = 0.f;
#pragma unroll
        for (int i = 0; i < 16; ++i) { acc[i] -= mean; q2 += acc[i] * acc[i]; }
        const float rstd = rsqrtf(wave_sum(q2) * (1.f / 1024.f) + LN_EPS);
        float* dst = r < NLAT ? outlat + (size_t)r * 1024 : outctx + (size_t)(r - NLAT) * 1024;
        float s2 = 0.f;
#pragma unroll
        for (int h = 0; h < 4; ++h) {
            const int i0 = ebase + 4 * h;
            const f32x4 a = *(const f32x4*)(lg + i0), bb = *(const f32x4*)(lb + i0);
            f32x4 o;
#pragma unroll
            for (int q = 0; q < 4; ++q) { o[q] = acc[4 * h + q] * rstd * a[q] + bb[q]; acc[4 * h + q] = o[q]; s2 += o[q]; }
            *(f32x4*)(dst + i0) = o;
        }
        if (fuse_next) {
            const float* sh = mods + (size_t)5 * 6144 + (size_t)mi * 6144; const float* sc = sh + 1024;
            const float mean2 = wave_sum(s2) * (1.f / 1024.f); float q3 = 0.f;
#pragma unroll
            for (int i = 0; i < 16; ++i) { acc[i] -= mean2; q3 += acc[i] * acc[i]; }
            const float rstd2 = rsqrtf(wave_sum(q3) * (1.f / 1024.f) + LN_EPS);
#pragma unroll
            for (int jj = 0; jj < 2; ++jj) {
                const int i0 = ebase + 8 * jj;
                const f32x4 a0 = *(const f32x4*)(sc + i0), a1 = *(const f32x4*)(sc + i0 + 4), c0 = *(const f32x4*)(sh + i0), c1 = *(const f32x4*)(sh + i0 + 4);
                uint4 o;
                o.x = pk2(acc[8 * jj + 0] * rstd2 * (1.f + a0[0]) + c0[0], acc[8 * jj + 1] * rstd2 * (1.f + a0[1]) + c0[1]);
                o.y = pk2(acc[8 * jj + 2] * rstd2 * (1.f + a0[2]) + c0[2], acc[8 * jj + 3] * rstd2 * (1.f + a0[3]) + c0[3]);
                o.z = pk2(acc[8 * jj + 4] * rstd2 * (1.f + a1[0]) + c1[0], acc[8 * jj + 5] * rstd2 * (1.f + a1[1]) + c1[1]);
                o.w = pk2(acc[8 * jj + 6] * rstd2 * (1.f + a1[2]) + c1[2], acc[8 * jj + 7] * rstd2 * (1.f + a1[3]) + c1[3]);
                *(uint4*)(XLN + (size_t)r * 1024 + i0) = o;
            }
        }
    }
}

__device__ __forceinline__ u32 f2sort(float f) { const u32 u = __float_as_uint(f); return u ^ ((u32)((int)u >> 31) | 0x80000000u); }
__device__ __forceinline__ float sort2f(u32 k) { return __uint_as_float((k & 0x80000000u) ? (k ^ 0x80000000u) : ~k); }
__device__ __forceinline__ void ins16(u32 (&L)[16], u32 x) {
#pragma unroll
    for (int j = 0; j < 16; ++j) { const u32 hi = L[j] > x ? L[j] : x; x = L[j] > x ? x : L[j]; L[j] = hi; }
}
__device__ __forceinline__ void ce_desc(u32& a, u32& b) { const u32 hi = a > b ? a : b, lo = a > b ? b : a; a = hi; b = lo; }
__device__ __forceinline__ void sort16(u32 (&C)[16]) {
#pragma unroll
    for (int k = 2; k <= 16; k <<= 1)
#pragma unroll
        for (int j = k >> 1; j > 0; j >>= 1)
#pragma unroll
            for (int i = 0; i < 16; ++i) { const int o = i ^ j; if (o > i) { if ((i & k) == 0) ce_desc(C[i], C[o]); else ce_desc(C[o], C[i]); } }
}
__device__ __forceinline__ void merge16(u32 (&L)[16], const u32 (&C)[16]) {
#pragma unroll
    for (int i = 0; i < 16; ++i) L[i] = L[i] > C[15 - i] ? L[i] : C[15 - i];
#pragma unroll
    for (int j = 8; j > 0; j >>= 1)
#pragma unroll
        for (int i = 0; i < 16; ++i) if ((i & j) == 0) ce_desc(L[i], L[i + j]);
}
__device__ __forceinline__ void ph_topk_fast(const Params& p, int l, int nrows, unsigned char* ldsg, int vb) {
    LAS unsigned char* lds = (LAS unsigned char*)ldsg;
    const int tid = opq_tid(), lane = tid & 63, fr = lane & 15, fq = lane >> 4;
    const int wave = __builtin_amdgcn_readfirstlane(tid >> 6); const int wr = wave >> 1, wc = wave & 1;
    const bf16_t* U = (const bf16_t*)(p.ws + OFF_U);
    const bf16_t* WT = (const bf16_t*)(p.ws + OFF_WQT) + (size_t)l * 2048 * 1024;
    const bf16_t* K12 = (const bf16_t*)(p.ws + OFF_K12);
    int* EIDX = (int*)(p.ws + OFF_EIDX); float* GATE = (float*)(p.ws + OFF_GATE);
    LAS u32* X = (LAS u32*)lds;
    LAS u32* T1 = (LAS u32*)(lds + 16384);
    LAS u32* T0 = (LAS u32*)(lds + 65536);
    const int srow = lane >> 3, sch = (lane & 7) ^ (lane >> 3);
    for (int it = 0;; ++it) {
        int m, h; if (!tile_sched(it, vb, nrows / 128, 8, m, h)) break;
        const int m0 = m * 128;
#pragma unroll 1
        for (int half = 0; half < 2; ++half) {
            f32x4 acc[4][4];
            gemm_tile<true>(acc, U + (size_t)m0 * 1024, 1024, WT + (size_t)(h * 256 + half * 128) * 1024, 1024, 1024, lds);
            __syncthreads();
#pragma unroll
            for (int mi = 0; mi < 4; ++mi) {
                const int row = 64 * wr + 16 * mi + fr;
#pragma unroll
                for (int ni = 0; ni < 4; ++ni) {
                    const uint2 v = pk4(acc[mi][ni]);
                    *(LAS u32x2*)(lds + wc * 32768 + row * 128 + (((2 * ni + (fq >> 1)) ^ (row & 7)) << 4) + (fq & 1) * 8) = (u32x2){v.x, v.y};
                }
            }
            const bf16_t* Kh = K12 + ((size_t)(half * 2 + l) * 8 + h) * 16384;
#pragma unroll
            for (int ks = 0; ks < 2; ++ks)
#pragma unroll
                for (int i = 0; i < 4; ++i) {
                    const int r = 32 * wave + 8 * i + srow;
                    __builtin_amdgcn_global_load_lds((const unsigned*)(Kh + (size_t)r * 128 + ks * 64 + sch * 8), (LAS unsigned*)(lds + ks * 32768 + 16384 + wave * 4096 + i * 1024), 16, 0, 0);
                }
            asm volatile("s_waitcnt vmcnt(0)" ::: "memory");
            __syncthreads();
            f32x4 sc[4][4];
#pragma unroll
            for (int mi = 0; mi < 4; ++mi)
#pragma unroll
                for (int ni = 0; ni < 4; ++ni) sc[mi][ni] = (f32x4){0.f, 0.f, 0.f, 0.f};
#pragma unroll
            for (int kk = 0; kk < 4; ++kk) {
                const LAS unsigned char* base = lds + (kk >> 1) * 32768;
                const int xo = (((kk & 1) * 4 + fq) ^ (fr & 7)) << 4;
                bf16x8 a[4], b[4];
#pragma unroll
                for (int mi = 0; mi < 4; ++mi) a[mi] = *(const LAS bf16x8*)(base + (wr * 64 + fr) * 128 + mi * 2048 + xo);
#pragma unroll
                for (int ni = 0; ni < 4; ++ni) b[ni] = *(const LAS bf16x8*)(base + 16384 + (wc * 64 + fr) * 128 + ni * 2048 + xo);
#pragma unroll
                for (int mi = 0; mi < 4; ++mi)
#pragma unroll
                    for (int ni = 0; ni < 4; ++ni) sc[mi][ni] = __builtin_amdgcn_mfma_f32_16x16x32_bf16(b[ni], a[mi], sc[mi][ni], 0, 0, 0);
            }
            __syncthreads();
#pragma unroll
            for (int mi = 0; mi < 4; ++mi) {
                const int row = 64 * wr + 16 * mi + fr;
#pragma unroll
                for (int ni = 0; ni < 4; ++ni) *(LAS f32x4*)(lds + row * 512 + (((16 * wc + 4 * ni + fq) ^ (row & 15)) << 4)) = sc[mi][ni];
            }
            __syncthreads();
            const int r = tid & 127, hs = tid >> 7;
            u32 L[16];
#pragma unroll
            for (int j = 0; j < 16; ++j) L[j] = 0u;
#pragma unroll 1
            for (int q4 = 0; q4 < 4; ++q4) {
                u32 C[16];
#pragma unroll
                for (int q = 0; q < 4; ++q) {
                    const int c4 = hs * 16 + q4 * 4 + q;
                    const f32x4 v = *(const LAS f32x4*)(lds + r * 512 + ((c4 ^ (r & 15)) << 4));
#pragma unroll
                    for (int e = 0; e < 4; ++e) C[4 * q + e] = (f2sort(v[e]) & ~127u) | (u32)(127 - (c4 * 4 + e));
                }
                sort16(C); merge16(L, C);
            }
            __syncthreads();
            if (hs == 1) {
#pragma unroll
                for (int j = 0; j < 16; ++j) X[r * 17 + j] = L[j];
            }
            __syncthreads();
            if (hs == 0) {
                u32 C[16];
#pragma unroll
                for (int j = 0; j < 16; ++j) C[j] = X[r * 17 + j];
                merge16(L, C);
                LAS u32* T = half == 0 ? T0 : T1;
#pragma unroll
                for (int j = 0; j < 16; ++j) T[r * 17 + j] = L[j];
            }
        }
        __syncthreads();
        if (tid < 128) {
            const int r = tid;
            float va[16], vbv[16];
#pragma unroll
            for (int a = 0; a < 16; ++a) { va[a] = sort2f(T0[r * 17 + a] & ~127u); vbv[a] = sort2f(T1[r * 17 + a] & ~127u); }
#define CKEY(a, b) ((f2sort(va[a] + vbv[b]) & ~255u) | (u32)(255 - ((a) * 16 + (b))))
            u32 L[16];
#pragma unroll
            for (int j = 0; j < 16; ++j) L[j] = CKEY(0, j);
            {
                u32 C[16];
#pragma unroll
                for (int b = 0; b < 8; ++b) C[b] = CKEY(1, b);
#pragma unroll
                for (int b = 0; b < 5; ++b) C[8 + b] = CKEY(2, b);
#pragma unroll
                for (int b = 0; b < 3; ++b) C[13 + b] = CKEY(4, b);
                sort16(C); merge16(L, C);
#pragma unroll
                for (int b = 0; b < 4; ++b) C[b] = CKEY(3, b);
#pragma unroll
                for (int a = 5; a < 8; ++a) { C[4 + 2 * (a - 5)] = CKEY(a, 0); C[5 + 2 * (a - 5)] = CKEY(a, 1); }
#pragma unroll
                for (int a = 8; a < 14; ++a) C[10 + (a - 8)] = CKEY(a, 0);
                sort16(C); merge16(L, C);
            }
            ins16(L, CKEY(14, 0)); ins16(L, CKEY(15, 0));
#undef CKEY
            const float mx = sort2f(L[0] & ~255u);
            float ge[16]; int eo[16]; float sum = 0.f;
#pragma unroll
            for (int j = 0; j < 16; ++j) {
                const u32 key = L[j]; const int pos = 255 - (int)(key & 255u);
                const int i1 = 127 - (int)(T0[r * 17 + (pos >> 4)] & 127u), i2 = 127 - (int)(T1[r * 17 + (pos & 15)] & 127u);
                eo[j] = i1 * 128 + i2;
                ge[j] = __expf(sort2f(key & ~255u) - mx); sum += ge[j];
            }
            const float inv = 1.f / sum;
            int* ed = EIDX + (size_t)(m0 + r) * 128 + h * 16; float* gd = GATE + (size_t)(m0 + r) * 128 + h * 16;
#pragma unroll
            for (int j = 0; j < 16; j += 4) {
                *(int4*)(ed + j) = make_int4(eo[j], eo[j + 1], eo[j + 2], eo[j + 3]);
                *(float4*)(gd + j) = make_float4(ge[j] * inv, ge[j + 1] * inv, ge[j + 2] * inv, ge[j + 3] * inv);
            }
        }
    }
}


#define NPHASES 21
#define PHASE_SKIP_MASK ((1u << 3) | (1u << 8) | (1u << 11) | (1u << 13) | (1u << 18))
__device__ __forceinline__ void run_phase(const Params& p, int ph, unsigned char* lds, volatile LAS unsigned* misc, int vb, int nblk) {
    LAS unsigned char* ldsl = (LAS unsigned char*)lds;
    if (ph == 0) {
        ph_prep_fast(p, lds, vb, nblk);
        return; }
    const int l = (ph - 1) / 10, s = (ph - 1) % 10;
    float* XC2 = (float*)(p.ws + OFF_XC2);
    const float* xlat = l == 0 ? p.in[0] : p.out; const float* xctx = l == 0 ? p.in[2] : XC2;
    const int nrows = l == 0 ? NROWS : NLAT;
    switch (s) {
    case 0: if (l == 0) ph_lnmod(p, l, xlat, xctx, vb, nblk); break;
    case 1: ph_inproj_fast(p, l, lds, vb, nblk); break;
    case 2: break;
    case 3: ph_mixers_fast(p, l, lds); break;
    case 4:
            ph_merge_fast(p, l, nrows, ldsl, vb); if (l == 0 && (vb >> 3) >= 8) euv_queue_work(p, misc, 8); break;
    case 5: ph_wout_fast(p, l, nrows, xlat, xctx, ldsl, vb); if (l == 0 && (vb >> 3) >= 8) euv_queue_work(p, misc, 8); break;
    case 6: ph_ln1(p, l, nrows, vb, nblk); break;
    case 7: break;
    case 8: ph_topk_fast(p, l, nrows, lds, vb); if (l == 0) euv_queue_work(p, misc, 8192); break;
    case 9: ph_expert_sub(p, l, nrows, p.out, XC2, l == 0, vb, nblk); break;
    }
}

#define LDS_BYTES (80 * 1024)
#define LDS_MISC_OFF (LDS_BYTES - 64)
__global__ void __launch_bounds__(NTHREADS, 2) mega(Params p) {
    extern __shared__ __attribute__((aligned(16))) unsigned char lds[];
    volatile LAS unsigned* misc = (volatile LAS unsigned*)((LAS unsigned char*)lds + LDS_MISC_OFF);
    if (threadIdx.x < 16) misc[threadIdx.x] = 0u;
    __syncthreads();
    XcdBarrier bar; bar.bar = (unsigned*)(p.ws + OFF_CTL); bar.x = 0; bar.st = misc;
    const bool multi = (p.ph_hi - p.ph_lo) > 1;
    if (multi) bar = xcd_barrier_post((unsigned*)(p.ws + OFF_CTL), misc);
    const int vb = blockIdx.x, nblk = gridDim.x;
    for (int ph = p.ph_lo; ph < p.ph_hi; ++ph) {
        if ((PHASE_SKIP_MASK >> ph) & 1) continue;
        run_phase(p, ph, lds, misc, vb, nblk);
        if (ph + 1 < p.ph_hi) xcd_barrier(bar);
    }
}

#ifndef N_LAUNCH_MODE
#define N_LAUNCH_MODE 1
#endif

extern "C" void kernel_launch(void* const* d_in, const int* in_sizes, int n_in, void* d_out, int out_size, void* d_ws, size_t ws_size, hipStream_t stream) {
    static int grid = 0;
    if (grid == 0) {
        if (n_in != 28 || ws_size < WS_END) { fprintf(stderr, "kernel_launch: unexpected n_in %d or ws_size %zu < %zu\n", n_in, ws_size, (size_t)WS_END); grid = -1; return; }
        int dev = 0, cus = 0, per_cu = 0;
        hipGetDevice(&dev); hipDeviceGetAttribute(&cus, hipDeviceAttributeMultiprocessorCount, dev);
        hipFuncSetAttribute((const void*)mega, hipFuncAttributeMaxDynamicSharedMemorySize, LDS_BYTES);
        hipOccupancyMaxActiveBlocksPerMultiprocessor(&per_cu, (const void*)mega, NTHREADS, LDS_BYTES);
        (void)hipGetLastError();
        if (per_cu < 1) per_cu = 1;
        if (per_cu > 2) per_cu = 2;
        grid = cus * per_cu;
    }
    if (grid < 0) return;
    hipMemsetAsync((char*)d_ws + OFF_CTL, 0, 65536, stream);
    Params p{};
    for (int i = 0; i < 28; ++i) p.in[i] = (const float*)d_in[i];
    p.out = (float*)d_out; p.ws = (unsigned char*)d_ws;
    p.ph_lo = 0; p.ph_hi = NPHASES;
    hipLaunchKernelGGL(mega, dim3(grid), dim3(NTHREADS), LDS_BYTES, stream, p);
}
```
